# Optimizing an MI355X kernel written in HIP

```python
import math
import jax, jax.numpy as jnp
from jax import lax
import numpy as np

D_MODEL = 1024
BATCH = 2
SEQ = 16384
DEPTH = 2

N_MIXERS = 2
N_SSM_LAYERS = (DEPTH + 1) // 2
N_CONV_LAYERS = DEPTH // 2
SSM_WIDTH = D_MODEL
SSM_GROUP = 16
SSM_GROUPS = SSM_WIDTH // SSM_GROUP
SSM_STATE = 64
SSM_CHUNK = 128
DT_MIN = 0.001
DT_MAX = 0.1
CONV_WIDTH = D_MODEL
CONV_K = 3
N_GROUPS = 4
EXPERTS_PER_GROUP = 8
N_EXPERTS = N_GROUPS * EXPERTS_PER_GROUP
TOP_K = 2
D_EXPERT = D_MODEL // 2
RMS_EPS = 1e-6

kernel_name = 'hybrid_s5_shortconv_hier_moe'


def rmsnorm(x, g):
    x32 = x.astype(jnp.float32)
    y = x32 * lax.rsqrt(jnp.mean(x32 * x32, axis=-1, keepdims=True) + RMS_EPS)
    return (y * g.astype(jnp.float32)).astype(x.dtype)


def modulate(h, shift, scale):
    return h * (1 + scale[:, None, :]) + shift[:, None, :]


def _complex_affine_combine(e1, e2):
    a1r, a1i, b1r, b1i = e1
    a2r, a2i, b2r, b2i = e2
    return (a2r * a1r - a2i * a1i,
            a2r * a1i + a2i * a1r,
            a2r * b1r - a2i * b1i + b2r,
            a2r * b1i + a2i * b1r + b2i)


def s5_mixer(h, w_in, lam_re, lam_im, log_dt, b_re, b_im, c_re, c_im, d_skip, w_glu):
    f32 = jnp.float32
    bsz, seq, _ = h.shape
    u = (h @ w_in).astype(f32)
    lr, li = lam_re.astype(f32), lam_im.astype(f32)
    dt = jnp.exp(log_dt.astype(f32))[:, None]
    mag = jnp.exp(lr * dt)
    ab_re = mag * jnp.cos(li * dt)
    ab_im = mag * jnp.sin(li * dt)
    den = lr * lr + li * li
    cf_re = ((ab_re - 1) * lr + ab_im * li) / den
    cf_im = (ab_im * lr - (ab_re - 1) * li) / den
    br, bi = b_re.astype(f32), b_im.astype(f32)
    bb_re = cf_re[..., None] * br - cf_im[..., None] * bi
    bb_im = cf_re[..., None] * bi + cf_im[..., None] * br
    cr, ci = c_re.astype(f32), c_im.astype(f32)
    n_chunks = seq // SSM_CHUNK
    uc = u.reshape(bsz, n_chunks, SSM_CHUNK, SSM_GROUPS, SSM_GROUP).transpose(1, 0, 2, 3, 4)
    blk_shape = (bsz, SSM_CHUNK, SSM_GROUPS, SSM_STATE)
    a_re = jnp.broadcast_to(ab_re, blk_shape)
    a_im = jnp.broadcast_to(ab_im, blk_shape)

    def chunk_step(carry, u_blk):
        h_re, h_im = carry
        bu_re = jnp.einsum('btgk,gpk->btgp', u_blk, bb_re)
        bu_im = jnp.einsum('btgk,gpk->btgp', u_blk, bb_im)
        A_re, A_im, S_re, S_im = lax.associative_scan(
            _complex_affine_combine, (a_re, a_im, bu_re, bu_im), axis=1)
        st_re = S_re + A_re * h_re[:, None] - A_im * h_im[:, None]
        st_im = S_im + A_re * h_im[:, None] + A_im * h_re[:, None]
        y = (jnp.einsum('btgp,gkp->btgk', st_re, cr)
             - jnp.einsum('btgp,gkp->btgk', st_im, ci))
        return (st_re[:, -1], st_im[:, -1]), y

    h0 = jnp.zeros((bsz, SSM_GROUPS, SSM_STATE), f32)
    _, ys = lax.scan(chunk_step, (h0, h0), uc)
    y = ys.transpose(1, 0, 2, 3, 4).reshape(bsz, seq, SSM_WIDTH) + d_skip.astype(f32) * u
    y = jax.nn.gelu(y).astype(h.dtype)
    val, gate = jnp.split(y @ w_glu, 2, axis=-1)
    return val * jax.nn.sigmoid(gate)


def short_conv_mixer(h, w_in, conv_w, w_out):
    b_g, c_g, v = jnp.split(h @ w_in, 3, axis=-1)
    u = c_g * v
    z = lax.conv_general_dilated(
        u, conv_w[:, None, :].astype(u.dtype), window_strides=(1,),
        padding=[(CONV_K - 1, 0)], dimension_numbers=('NWC', 'WIO', 'NWC'),
        feature_group_count=CONV_WIDTH)
    return (b_g * z) @ w_out


def hier_moe(h, wg, bg, we, be, w1, w3, w2):
    f32 = jnp.float32
    bsz, seq, d = h.shape
    T = bsz * seq
    hf = h.reshape(T, d)
    g_prob = jax.nn.softmax((hf @ wg).astype(f32) + bg.astype(f32), axis=-1)
    gp, gi = lax.top_k(g_prob, 1)
    e_logits = ((hf @ we).astype(f32) + be.astype(f32)).reshape(T, N_GROUPS, EXPERTS_PER_GROUP)
    e_sel = jnp.take_along_axis(e_logits, gi[:, :, None], axis=1)[:, 0]
    ev, ei = lax.top_k(e_sel, TOP_K)
    wts = gp * jax.nn.softmax(ev, axis=-1)
    eid = gi * EXPERTS_PER_GROUP + ei
    flat_e = eid.reshape(-1)
    order = jnp.argsort(flat_e)
    tok = order // TOP_K
    sizes = jnp.bincount(flat_e, length=N_EXPERTS).astype(jnp.int32)
    xs = hf[tok]
    a = lax.ragged_dot(xs, w1, sizes)
    b = lax.ragged_dot(xs, w3, sizes)
    o = lax.ragged_dot(jax.nn.silu(a) * b, w2, sizes)
    o = o * wts.reshape(-1)[order][:, None].astype(o.dtype)
    y = jnp.zeros_like(hf).at[tok].add(o)
    return y.reshape(bsz, seq, d)


def setup_inputs(seed: int = 0) -> dict:
    f32 = jnp.float32
    key = jax.random.key(seed)
    ks = jax.random.split(key, 32)

    def nrm(k, shape, scale):
        return jax.random.normal(k, shape, f32) * scale

    n_idx = jnp.arange(SSM_STATE, dtype=f32)
    ssm_shape = (N_SSM_LAYERS, SSM_GROUPS, SSM_STATE)
    return {
        'x': nrm(ks[0], (BATCH, SEQ, D_MODEL), 1.0),
        'c': nrm(ks[1], (BATCH, D_MODEL), 1.0),
        'ada_w': nrm(ks[2], (DEPTH, D_MODEL, 6 * D_MODEL), 0.1 * D_MODEL ** -0.5),
        'ada_b': nrm(ks[3], (DEPTH, 6 * D_MODEL), 0.02),
        'norm1_g': 1.0 + nrm(ks[4], (DEPTH, D_MODEL), 0.02),
        'norm2_g': 1.0 + nrm(ks[5], (DEPTH, D_MODEL), 0.02),
        'ssm_w_in': nrm(ks[6], (N_SSM_LAYERS, D_MODEL, SSM_WIDTH), D_MODEL ** -0.5),
        'ssm_lam_re': -0.5 + nrm(ks[7], ssm_shape, 0.01),
        'ssm_lam_im': math.pi * n_idx + nrm(ks[8], ssm_shape, 0.01),
        'ssm_log_dt': jax.random.uniform(ks[9], (N_SSM_LAYERS, SSM_GROUPS), f32,
                                         math.log(DT_MIN), math.log(DT_MAX)),
        'ssm_b_re': nrm(ks[10], (N_SSM_LAYERS, SSM_GROUPS, SSM_STATE, SSM_GROUP), (2 * SSM_GROUP) ** -0.5),
        'ssm_b_im': nrm(ks[11], (N_SSM_LAYERS, SSM_GROUPS, SSM_STATE, SSM_GROUP), (2 * SSM_GROUP) ** -0.5),
        'ssm_c_re': nrm(ks[12], (N_SSM_LAYERS, SSM_GROUPS, SSM_GROUP, SSM_STATE), SSM_STATE ** -0.5),
        'ssm_c_im': nrm(ks[13], (N_SSM_LAYERS, SSM_GROUPS, SSM_GROUP, SSM_STATE), SSM_STATE ** -0.5),
        'ssm_d': nrm(ks[14], (N_SSM_LAYERS, SSM_WIDTH), 1.0),
        'ssm_w_glu': nrm(ks[15], (N_SSM_LAYERS, SSM_WIDTH, 2 * D_MODEL), SSM_WIDTH ** -0.5),
        'conv_w_in': nrm(ks[16], (N_CONV_LAYERS, D_MODEL, 3 * CONV_WIDTH), D_MODEL ** -0.5),
        'conv_w': nrm(ks[17], (N_CONV_LAYERS, CONV_K, CONV_WIDTH), CONV_K ** -0.5),
        'conv_w_out': nrm(ks[18], (N_CONV_LAYERS, CONV_WIDTH, D_MODEL), CONV_WIDTH ** -0.5),
        'moe_wg': nrm(ks[19], (DEPTH, D_MODEL, N_GROUPS), D_MODEL ** -0.5),
        'moe_bg': nrm(ks[20], (DEPTH, N_GROUPS), 0.01),
        'moe_we': nrm(ks[21], (DEPTH, D_MODEL, N_EXPERTS), D_MODEL ** -0.5),
        'moe_be': nrm(ks[22], (DEPTH, N_EXPERTS), 0.01),
        'moe_w1': nrm(ks[23], (DEPTH, N_EXPERTS, D_MODEL, D_EXPERT), D_MODEL ** -0.5),
        'moe_w3': nrm(ks[24], (DEPTH, N_EXPERTS, D_MODEL, D_EXPERT), D_MODEL ** -0.5),
        'moe_w2': nrm(ks[25], (DEPTH, N_EXPERTS, D_EXPERT, D_MODEL), D_EXPERT ** -0.5),
        'final_g': 1.0 + nrm(ks[26], (D_MODEL,), 0.02),
    }


def reference(x, c, ada_w, ada_b, norm1_g, norm2_g,
              ssm_w_in, ssm_lam_re, ssm_lam_im, ssm_log_dt, ssm_b_re, ssm_b_im,
              ssm_c_re, ssm_c_im, ssm_d, ssm_w_glu,
              conv_w_in, conv_w, conv_w_out,
              moe_wg, moe_bg, moe_we, moe_be, moe_w1, moe_w3, moe_w2, final_g):
    cond = jax.nn.silu(c)
    for i in range(DEPTH):
        mod = cond @ ada_w[i] + ada_b[i]
        sh1, sc1, g1, sh2, sc2, g2 = jnp.split(mod, 6, axis=-1)
        hn = modulate(rmsnorm(x, norm1_g[i]), sh1, sc1)
        j = i // N_MIXERS
        if i % N_MIXERS == 0:
            out = s5_mixer(hn, ssm_w_in[j], ssm_lam_re[j], ssm_lam_im[j], ssm_log_dt[j],
                           ssm_b_re[j], ssm_b_im[j], ssm_c_re[j], ssm_c_im[j],
                           ssm_d[j], ssm_w_glu[j])
        else:
            out = short_conv_mixer(hn, conv_w_in[j], conv_w[j], conv_w_out[j])
        x = x + (1 + g1)[:, None, :] * out
        hn = modulate(rmsnorm(x, norm2_g[i]), sh2, sc2)
        x = x + (1 + g2)[:, None, :] * hier_moe(hn, moe_wg[i], moe_bg[i], moe_we[i], moe_be[i],
                                                moe_w1[i], moe_w3[i], moe_w2[i])
    return rmsnorm(x, final_g)
```

```cpp
#include <hip/hip_runtime.h>
#include <cstdio>
#include <cstdint>
#include <type_traits>

#ifndef MK_MULTI
#define MK_MULTI 0
#endif

#define GAS __attribute__((address_space(1)))
#define LAS __attribute__((address_space(3)))
typedef unsigned short bf16;
typedef unsigned v4u __attribute__((ext_vector_type(4)));
typedef unsigned v2u __attribute__((ext_vector_type(2)));
typedef float f32x4 __attribute__((ext_vector_type(4)));
typedef float f32x2 __attribute__((ext_vector_type(2)));
typedef short bf16x8 __attribute__((ext_vector_type(8)));

constexpr int NTOK = 32768, D = 1024, SEQ = 16384;
constexpr int NGRP = 64, NST = 64, GCH = 16, LC = 32;
constexpr int NCH = NTOK / LC;
constexpr int UPITCH = 640;
constexpr int NEXP = 32, DEXP = 512;
constexpr float RMS_EPS = 1e-6f;
constexpr int NWAVES = 8;

constexpr size_t MiB = 1u << 20;
constexpr size_t WS_CTL = 0, CTL_ZERO_BYTES = 128 * 1024;
constexpr size_t WS_RBIAS = 192 * 1024;
constexpr size_t WS_WRF = 256 * 1024;
constexpr size_t WS_MOD = 1 * MiB;
constexpr size_t WS_SC = 1 * MiB + 512 * 1024;
constexpr size_t WS_WR = 1 * MiB + 640 * 1024;
constexpr size_t WS_WIN = 2 * MiB, WS_WGLU = 4 * MiB, WS_WCIN = 8 * MiB, WS_WCOUT = 14 * MiB;
constexpr size_t WS_BM = 16 * MiB;
constexpr size_t WS_LISTI = 16 * MiB, WS_LISTW = 20 * MiB;
constexpr size_t WS_BT = 24 * MiB;
constexpr size_t WS_CM = 26 * MiB;
constexpr size_t WS_W13 = 64 * MiB;
constexpr size_t WS_W2 = 192 * MiB;
constexpr size_t WS_XN = 256 * MiB;
constexpr size_t WS_SCR = 320 * MiB;
constexpr size_t WS_XB = WS_SCR;
constexpr size_t WS_UG = WS_SCR, WS_SB = WS_SCR + 80 * MiB, WS_GG = WS_SCR + 112 * MiB;
constexpr size_t WS_BG = WS_SCR + 64 * MiB, WS_UU = WS_W13, WS_A3 = WS_SCR + 192 * MiB;
constexpr size_t WS_HB = WS_SCR + 64 * MiB, WS_O2 = WS_SCR + 136 * MiB;
constexpr size_t WS_END = 584 * MiB;
constexpr int CW_BAR = 4096;
constexpr int CW_CNT = 16384;

constexpr int L_STAGE = 0;
constexpr int L_LIST = 133120;
constexpr int L_UT = 145408;
constexpr int L_CNT = 145664;
constexpr int L_RED = 149504;
constexpr int L_TOK = 151808;
constexpr int L_LCNT = 153856;
constexpr int L_MISC = 155520;
constexpr int LDS_BYTES = 155648;
constexpr int MAXU = 6;

#define LDS_WAIT() asm volatile("s_waitcnt lgkmcnt(0)" ::: "memory")
#define VM_WAIT() asm volatile("s_waitcnt vmcnt(0)" ::: "memory")
__device__ __forceinline__ unsigned f2bf(float f) { unsigned u = __builtin_bit_cast(unsigned, f); return (u + 0x7fffu + ((u >> 16) & 1u)) >> 16; }
typedef __bf16 bf16x2_t __attribute__((ext_vector_type(2)));
__device__ __forceinline__ unsigned pk2(float lo, float hi) { const f32x2 v = {lo, hi}; return __builtin_bit_cast(unsigned, __builtin_convertvector(v, bf16x2_t)); }
__device__ __forceinline__ float bf_lo(unsigned w) { return __builtin_bit_cast(float, w << 16); }
__device__ __forceinline__ float bf_hi(unsigned w) { return __builtin_bit_cast(float, w & 0xffff0000u); }
constexpr float FS_XN = 16.f, FS_W13 = 64.f, FS_H = 8.f, FS_W2 = 64.f, FS_O = 16.f, FS_A3 = 8.f, FS_WCO = 64.f;
__device__ __forceinline__ unsigned pk4_fp8(float a, float b, float c, float d) { int p = __builtin_amdgcn_cvt_pk_fp8_f32(a, b, 0, false); p = __builtin_amdgcn_cvt_pk_fp8_f32(c, d, p, true); return (unsigned)p; }
__device__ __forceinline__ void unpack8_fp8(v2u q, float (&f)[8]) {
    typedef float f32x2_ __attribute__((ext_vector_type(2)));
    const f32x2_ a = __builtin_amdgcn_cvt_pk_f32_fp8((int)q.x, false), b = __builtin_amdgcn_cvt_pk_f32_fp8((int)q.x, true), c = __builtin_amdgcn_cvt_pk_f32_fp8((int)q.y, false), d = __builtin_amdgcn_cvt_pk_f32_fp8((int)q.y, true);
    f[0] = a[0]; f[1] = a[1]; f[2] = b[0]; f[3] = b[1]; f[4] = c[0]; f[5] = c[1]; f[6] = d[0]; f[7] = d[1]; }
__device__ __forceinline__ float sat_fp8(float x) { return __builtin_amdgcn_fmed3f(x, -448.f, 448.f); }
__device__ __forceinline__ unsigned cvt_pk_bf16(float lo, float hi) { unsigned r; asm volatile("v_cvt_pk_bf16_f32 %0, %1, %2" : "=v"(r) : "v"(lo), "v"(hi)); return r; }
__device__ __forceinline__ float shx(float v, int mask, int lane) { return __builtin_bit_cast(float, __builtin_amdgcn_ds_bpermute((lane ^ mask) << 2, __builtin_bit_cast(int, v))); }
__device__ __forceinline__ int shi(int v, int src, int lane) { (void)lane; return __builtin_amdgcn_ds_bpermute(src << 2, v); }
__device__ __forceinline__ float dpp_add(float v, int ctrl_sel) {
    const int vi = __builtin_bit_cast(int, v); int r;
    if (ctrl_sel == 0) r = __builtin_amdgcn_update_dpp(0, vi, 0xB1, 0xf, 0xf, true);
    else if (ctrl_sel == 1) r = __builtin_amdgcn_update_dpp(0, vi, 0x4E, 0xf, 0xf, true);
    else if (ctrl_sel == 2) r = __builtin_amdgcn_update_dpp(0, vi, 0x141, 0xf, 0xf, true);
    else r = __builtin_amdgcn_update_dpp(0, vi, 0x140, 0xf, 0xf, true);
    return v + __builtin_bit_cast(float, r);
}
__device__ __forceinline__ float wave_sum(float v, int lane) {
    v = dpp_add(v, 0); v = dpp_add(v, 1); v = dpp_add(v, 2); v = dpp_add(v, 3);
    v += shx(v, 16, lane); v += shx(v, 32, lane);
    return v;
}
__device__ __forceinline__ float sigmoidf_(float x) { return __builtin_amdgcn_rcpf(1.0f + __builtin_amdgcn_exp2f(-1.4426950408889634f * x)); }
__device__ __forceinline__ float gelu_tanh(float x) { const float x2 = x * x, u = x * (-2.3022082f - 0.10294324f * x2); return x * __builtin_amdgcn_rcpf(1.0f + __builtin_amdgcn_exp2f(u)); }

__device__ __forceinline__ int fresh_lane() { unsigned m_ = ~0u; asm volatile("" : "+s"(m_)); return (int)__builtin_amdgcn_mbcnt_hi(m_, __builtin_amdgcn_mbcnt_lo(m_, 0u)); }
#define XB_TMO      128
#define XB_XCNT(j)  (256  + 64 * (j))
#define XB_XSUB(j)  (1280 + 64 * (j))
#define XB_XGEN(j)  (2304 + 64 * (j))
#define XB_TOP      3328
#define XB_TOPGEN   3392
#define XCD_BAR_WORDS 3456
#define XB_SPIN_CAP (1u << 18)
__device__ __forceinline__ unsigned xb_ld(unsigned* p)              { return __hip_atomic_load(p, __ATOMIC_RELAXED, __HIP_MEMORY_SCOPE_AGENT); }
__device__ __forceinline__ unsigned xb_add(unsigned* p, unsigned v) { return __hip_atomic_fetch_add(p, v, __ATOMIC_RELAXED, __HIP_MEMORY_SCOPE_AGENT); }
__device__ __forceinline__ unsigned xb_xcc_id() { return (unsigned)__builtin_amdgcn_s_getreg((3 << 11) | 20) & 0xFu; }
#define XB_SPIN(cond, bar) do { unsigned _sp = 0; while (cond) { __builtin_amdgcn_s_sleep(1); \
    if ((++_sp & 255u) == 0u) { if (xb_ld(&(bar)[XB_TMO])) break; if (_sp > XB_SPIN_CAP) { atomicAdd(&(bar)[XB_TMO], 1u); break; } } } } while (0)
struct XcdBarrier { unsigned* bar; unsigned x; volatile LAS unsigned* st; };
__device__ __forceinline__ XcdBarrier xcd_barrier_post(unsigned* bar, volatile LAS unsigned* st, int wave) {
    XcdBarrier b; b.bar = bar; b.x = xb_xcc_id(); b.st = st;
    if (wave == 0 && fresh_lane() == 0) st[3] = xb_add(&bar[XB_XCNT(b.x)], 1u);
    return b;
}
__device__ __forceinline__ void xcd_barrier_complete(unsigned* bar, unsigned x, unsigned& nloc, unsigned& nx, unsigned& full) {
    const unsigned G = gridDim.x * gridDim.y * gridDim.z;
    unsigned sum, cnt, mine, sp = 0u;
    for (;;) {
        sum = 0u; cnt = 0u; mine = 0u; full = 0u;
#pragma unroll
        for (unsigned j = 0; j < 16; ++j) { const unsigned c = xb_ld(&bar[XB_XCNT(j)]); sum += c; cnt += (c > 0u) ? 1u : 0u; mine = (j == x) ? c : mine; full += (j < 8u && c == 32u) ? 1u : 0u; }
        if (sum == G) break;
        __builtin_amdgcn_s_sleep(1);
        if ((++sp & 255u) == 0u) { if (xb_ld(&bar[XB_TMO])) break; if (sp > XB_SPIN_CAP) { atomicAdd(&bar[XB_TMO], 1u); break; } }
    }
    nloc = mine > 0u ? mine : 1u; nx = cnt > 0u ? cnt : 1u;
}
template <bool LOCAL = false>
__device__ __forceinline__ void xcd_barrier(const XcdBarrier& b, int wave) {
    asm volatile("s_waitcnt vmcnt(0)" ::: "memory");
    __syncthreads();
    if (wave == 0 && fresh_lane() == 0) {
        unsigned* bar = b.bar;
        __builtin_amdgcn_s_waitcnt(0);
        unsigned nloc = b.st[0], nx = b.st[1];
        if (nloc == 0u) { unsigned full; xcd_barrier_complete(bar, b.x, nloc, nx, full); b.st[0] = nloc; b.st[1] = nx; b.st[2] = (full == 8u && nx == 8u && gridDim.x == 256u) ? 1u : 0u; }
        const unsigned old = xb_add(&bar[XB_XSUB(b.x)], 1u);
        const unsigned gen = old / nloc;
        if (old + 1u == (gen + 1u) * nloc) {
            if (!(LOCAL && b.st[2] != 0u)) {
                __builtin_amdgcn_fence(__ATOMIC_RELEASE, "agent");
                asm volatile("s_waitcnt vmcnt(0)" ::: "memory");
                const unsigned og = xb_add(&bar[XB_TOP], 1u);
                const unsigned tg = og / nx;
                if (og + 1u == (tg + 1u) * nx) xb_add(&bar[XB_TOPGEN], 1u);
                else XB_SPIN(xb_ld(&bar[XB_TOPGEN]) == tg, bar);
            }
            __builtin_amdgcn_fence(__ATOMIC_ACQUIRE, "agent");
            xb_add(&bar[XB_XGEN(b.x)], 1u);
            asm volatile("s_waitcnt vmcnt(0)" ::: "memory");
        } else {
            XB_SPIN(xb_ld(&bar[XB_XGEN(b.x)]) == gen, bar);
            __builtin_amdgcn_fence(__ATOMIC_ACQUIRE, "agent");
            asm volatile("s_waitcnt vmcnt(0)" ::: "memory");
        }
    }
    __syncthreads();
}

struct Args { const float* in[27]; float* out; unsigned char* ws; int ph_lo, ph_hi; };
#define CAS __attribute__((address_space(4)))
struct KArgs {
    const CAS char* kp;
    __device__ __forceinline__ const float* in(int k) const { return *(const float* const CAS*)(kp + 8 * k); }
    __device__ __forceinline__ float* out() const { return *(float* const CAS*)(kp + 8 * 27); }
    __device__ __forceinline__ unsigned char* ws() const { return *(unsigned char* const CAS*)(kp + 8 * 28); }
};
__device__ __forceinline__ KArgs fresh_args() { KArgs k; k.kp = (const CAS char*)__builtin_amdgcn_kernarg_segment_ptr(); asm volatile("" : "+s"(k.kp)); return k; }

namespace gm {
constexpr int BM = 256, BK = 64, HALF = 128, HTB = HALF * BK * 2, STAGE_BYTES = 8 * HTB, NXCD = 8, WGM = 8;
__host__ __device__ __forceinline__ int lds_byte(int r, int c) { const int st = (r >> 4) * 2 + (c >> 5), rr = r & 15, cc = c & 31, ob = rr * 64 + cc * 2; return st * 1024 + (ob ^ (((ob >> 9) & 1) << 5)); }
__host__ __device__ __forceinline__ void stage_rc(int b, int& R, int& C) { const int st = b / 1024, sb = b % 1024, swz = sb ^ (((sb >> 9) & 1) << 5); R = (st >> 1) * 16 + swz / 64; C = (st & 1) * 32 + (swz % 64) / 2; }
__host__ __device__ __forceinline__ int perm32(int rho) { const int n = rho >> 4, i = rho & 15; return 8 * (i >> 2) + 4 * n + (i & 3); }

struct Unit { const char* A; const char* B; const char* B2; int p0, p1, p2, p3; int nt, kjump; int hm; };

typedef int v8i __attribute__((ext_vector_type(8)));
typedef int v4i_ __attribute__((ext_vector_type(4)));
__device__ __forceinline__ v8i cat8(bf16x8 lo, bf16x8 hi) { const v4i_ a = __builtin_bit_cast(v4i_, lo), b = __builtin_bit_cast(v4i_, hi); return __builtin_shufflevector(a, b, 0, 1, 2, 3, 4, 5, 6, 7); }
template <class Epi, class Sched, bool ALIGN_EPI>
__device__ __forceinline__ void gemm_phase(LAS unsigned char* lds, const Sched& S, const Epi& E, int wave_) {
    int tid_ = wave_ * 64 + fresh_lane(); asm volatile("" : "+v"(tid_));
    const int tid = tid_, wid = __builtin_amdgcn_readfirstlane(tid >> 6), lane = tid & 63, wr = wid >> 2, wc = wid & 3, fr = lane & 15, fq = lane >> 4;
    int nt = S.nt; int kjump = 0;
    const long kstepA = S.kstepA, kstepB = S.kstepB, hstepA = S.hstepA, hstepB = Epi::PERM2 ? S.hstepB / 16 : S.hstepB;
    unsigned voffA[2], voffB[2], voffB2[2] = {0u, 0u}; long hstepB2 = 0; if constexpr (Sched::BSPLIT) hstepB2 = S.hstepB2;
#pragma unroll
    for (int i = 0; i < 2; ++i) { int R, C; stage_rc(tid * 16 + i * 8192, R, C); const int Rb = Epi::PERM2 ? (64 * (R >> 5) + 16 * ((R >> 2) & 3) + 4 * ((R >> 4) & 1) + (R & 3)) : Epi::PERM ? ((R & ~31) + perm32(R & 31)) : R;
        voffA[i] = S.voffA(R, C); voffB[i] = S.voffB(Rb, C); if constexpr (Sched::BSPLIT) voffB2[i] = S.voffB2(Rb, C); }
    unsigned goff[2][2] = {{0u, 0u}, {0u, 0u}};
    const unsigned ldsw = (unsigned)wid * 1024u;
    const int aoff = lds_byte(wr * 64 + fr, fq * 8), boff = lds_byte(wc * 32 + fr, fq * 8);
#define G_SA(b, h) (((b) * 2 + (h)) * HTB)
#define G_SB(b, h) ((4 + (b) * 2 + (h)) * HTB)
#define G_STAGE(bufoff, gbase, voff) do { _Pragma("unroll") for (int _i = 0; _i < 2; ++_i) \
        __builtin_amdgcn_global_load_lds((const unsigned*)((const char*)(gbase) + (voff)[_i]), (LAS unsigned*)(lds + (bufoff) + ldsw + _i * 8192), 16, 0, 0); } while (0)
#define G_STAGE_A(b, h, p) do { if constexpr (Sched::GATHER) { G_STAGE(G_SA(b, h), (p), goff[h]); } else { G_STAGE(G_SA(b, h), (p) + ((h) ? hstepA : 0), voffA); } } while (0)
#define G_STAGE_B(b, h, p) G_STAGE(G_SB(b, h), (p) + ((h) ? hstepB : 0), voffB)
#define G_STAGE_B2(b, h, p, c2) do { if constexpr (Sched::BSPLIT) { unsigned vs_[2]; vs_[0] = (c2) ? voffB2[0] : voffB[0]; vs_[1] = (c2) ? voffB2[1] : voffB[1]; G_STAGE(G_SB(b, h), (p) + ((h) ? ((c2) ? hstepB2 : hstepB) : 0), vs_); } else G_STAGE_B(b, h, p); } while (0)
#define G_LDA(dst, b, h) do { _Pragma("unroll") for (int m = 0; m < 4; ++m) _Pragma("unroll") for (int k = 0; k < 2; ++k) dst[m][k] = *(const LAS bf16x8*)(lds + G_SA(b, h) + aoff + m * 2048 + k * 1024); } while (0)
#define G_LDB(dst, b, h) do { _Pragma("unroll") for (int n = 0; n < 2; ++n) _Pragma("unroll") for (int k = 0; k < 2; ++k) dst[n][k] = *(const LAS bf16x8*)(lds + G_SB(b, h) + boff + n * 2048 + k * 1024); } while (0)
#define G_MMA(ai, bj, At, Bt) do { __builtin_amdgcn_s_setprio(1); _Pragma("unroll") for (int m = 0; m < 4; ++m) _Pragma("unroll") for (int n = 0; n < 2; ++n) { \
        if constexpr (Sched::FP8) { const v8i a8_ = cat8(Bt[n][0], Bt[n][1]), b8_ = cat8(At[m][0], At[m][1]); \
            asm volatile("v_mfma_f32_16x16x128_f8f6f4 %0, %1, %2, %0" : "+v"(acc[ai][bj][m][n]) : "v"(a8_), "v"(b8_)); }     \
        else { _Pragma("unroll") for (int k = 0; k < 2; ++k) acc[ai][bj][m][n] = __builtin_amdgcn_mfma_f32_16x16x32_bf16(Bt[n][k], At[m][k], acc[ai][bj][m][n], 0, 0, 0); } } \
        __builtin_amdgcn_s_setprio(0); } while (0)
#define G_WAIT_V(n) asm volatile("s_waitcnt vmcnt(" #n ")" ::: "memory")
#define G_WAIT_L(n) asm volatile("s_waitcnt lgkmcnt(" #n ")" ::: "memory")
#define G_BAR __builtin_amdgcn_s_barrier()
#define G_SCHED __builtin_amdgcn_sched_barrier(0)
#define G_LOAD_GOFF(ui_, hm_) do { const LAS unsigned* _rl = S.rowlist(ui_) + ((hm_) == 2 ? 128 : 0); const int _r1 = (hm_) ? 0 : 128; _Pragma("unroll") for (int _i = 0; _i < 2; ++_i) { int _R, _C; stage_rc(tid * 16 + _i * 8192, _R, _C); \
        goff[0][_i] = ((_rl[_R] >> 1) & 0x7fffu) * 1024u + (unsigned)(_C * 2); goff[1][_i] = ((_rl[_r1 + _R] >> 1) & 0x7fffu) * 1024u + (unsigned)(_C * 2); } } while (0)
    Unit cur, nxt; int ui = 0;
    if (!S.next(0, cur)) return;
    f32x4 acc[2][2][4][2];
#pragma unroll
    for (int a = 0; a < 2; ++a)
#pragma unroll
        for (int b = 0; b < 2; ++b)
#pragma unroll
            for (int m = 0; m < 4; ++m)
#pragma unroll
                for (int n = 0; n < 2; ++n) acc[a][b][m][n] = (f32x4){0.f, 0.f, 0.f, 0.f};
    bf16x8 At[4][2], B0[2][2], B1[2][2];
    const char* cA = cur.A; const char* cB = cur.B; const char* cB2 = nullptr; if constexpr (Sched::BSPLIT) cB2 = cur.B2;
    if constexpr (Sched::KJUMP) { nt = cur.nt; kjump = cur.kjump; }
    int hm = 0; if constexpr (Sched::HALFM) hm = cur.hm;
    if constexpr (Sched::GATHER) { G_LOAD_GOFF(0, hm); LDS_WAIT(); }
    G_STAGE_B(0, 0, cB); G_STAGE_A(0, 0, cA); G_STAGE_B(0, 1, cB); G_STAGE_A(0, 1, cA);
    if (wr == 1) G_BAR;
    G_WAIT_V(4); G_BAR;
    G_STAGE_B(1, 0, cB + kstepB); G_STAGE_A(1, 0, cA + kstepA); G_STAGE_B(1, 1, cB + kstepB);
    G_WAIT_V(6); G_BAR;
    for (;;) {
        const bool has_next = S.next(ui + 1, nxt);
        const char* nA = has_next ? nxt.A : cA; const char* nB = has_next ? nxt.B : cB;
        for (int t = 0; t < nt; t += 2) {
            const bool last = (t == nt - 2);
#define KO_(kt) ((long)((kt) + ((Sched::KJUMP && (kt) >= 4) ? kjump : 0)))
            const char* a1 = cA + KO_(t + 1) * kstepA;
            const bool c2 = Sched::BSPLIT && !last && KO_(t + 2) >= 8, c3 = Sched::BSPLIT && !last && KO_(t + 3) >= 8;
            const char* a2 = last ? nA : cA + KO_(t + 2) * kstepA; const char* b2 = last ? nB : (c2 ? cB2 + (KO_(t + 2) - 8) * kstepB : cB + KO_(t + 2) * kstepB);
            const char* a3 = last ? nA + kstepA : cA + KO_(t + 3) * kstepA; const char* b3 = last ? nB + kstepB : (c3 ? cB2 + (KO_(t + 3) - 8) * kstepB : cB + KO_(t + 3) * kstepB);
#undef KO_
            G_LDB(B0, 0, 0); G_SCHED; G_LDA(At, 0, 0); G_STAGE_A(1, 1, a1);
            G_WAIT_L(8); G_BAR; G_WAIT_L(0); G_MMA(0, 0, At, B0); G_BAR; G_SCHED;
            if constexpr (!Sched::HALFN) G_LDB(B1, 0, 1);
            G_STAGE_B2(0, 0, b2, c2);
            if constexpr (Sched::GATHER) { if (last && has_next) { G_LOAD_GOFF(ui + 1, nxt.hm); } }
            G_BAR; G_WAIT_L(0); if constexpr (!Sched::HALFN) G_MMA(0, 1, At, B1); G_BAR;
            if (!(Sched::HALFM && hm)) G_LDA(At, 0, 1);
            G_STAGE_A(0, 0, a2);
            G_BAR; G_WAIT_L(0); if (!(Sched::HALFM && hm)) G_MMA(1, 0, At, B0); G_BAR; G_SCHED;
            G_STAGE_B2(0, 1, b2, c2);
            G_WAIT_V(6); G_BAR; if constexpr (!Sched::HALFN) { if (!(Sched::HALFM && hm)) G_MMA(1, 1, At, B1); } G_BAR;
            G_LDB(B0, 1, 0); G_SCHED; G_LDA(At, 1, 0); G_STAGE_A(0, 1, a2);
            G_WAIT_L(8); G_BAR; G_WAIT_L(0); G_MMA(0, 0, At, B0); G_BAR; G_SCHED;
            if constexpr (!Sched::HALFN) G_LDB(B1, 1, 1);
            G_STAGE_B2(1, 0, b3, c3);
            G_BAR; G_WAIT_L(0); if constexpr (!Sched::HALFN) G_MMA(0, 1, At, B1); G_BAR;
            if (!(Sched::HALFM && hm)) G_LDA(At, 1, 1);
            G_STAGE_A(1, 0, a3);
            G_BAR; G_WAIT_L(0); if (!(Sched::HALFM && hm)) G_MMA(1, 0, At, B0); G_BAR; G_SCHED;
            G_STAGE_B2(1, 1, b3, c3);
            G_WAIT_V(6); G_BAR; if constexpr (!Sched::HALFN) { if (!(Sched::HALFM && hm)) G_MMA(1, 1, At, B1); } G_BAR;
        }
        if constexpr (ALIGN_EPI) { if (wr == 0) G_BAR; }
        if constexpr (Sched::FP8) asm volatile("s_nop 15\n\ts_nop 15" ::: "memory");
        E(acc, cur, wr, wc, fr, fq);
#ifdef PROBE_EPI2
        if constexpr (Epi::PERM || true) { asm volatile("" ::: "memory"); if (!Epi::NOTIDEM) E(acc, cur, wr, wc, fr, fq); }
#endif
        if (!has_next) break;
#pragma unroll
        for (int a = 0; a < 2; ++a)
#pragma unroll
            for (int b = 0; b < 2; ++b)
#pragma unroll
                for (int m = 0; m < 4; ++m)
#pragma unroll
                    for (int n = 0; n < 2; ++n) acc[a][b][m][n] = (f32x4){0.f, 0.f, 0.f, 0.f};
        cur = nxt; cA = nA; cB = nB; if constexpr (Sched::BSPLIT) cB2 = cur.B2; ++ui; if constexpr (Sched::KJUMP) { nt = cur.nt; kjump = cur.kjump; } if constexpr (Sched::HALFM) hm = cur.hm;
        if constexpr (ALIGN_EPI) { if (wr == 1) G_BAR; }
    }
    G_WAIT_V(0);
    if constexpr (!ALIGN_EPI) { if (wr == 0) G_BAR; }
    G_BAR;
#undef G_SA
#undef G_SB
#undef G_STAGE
#undef G_STAGE_A
#undef G_STAGE_B
#undef G_STAGE_B2
#undef G_LDA
#undef G_LDB
#undef G_MMA
#undef G_WAIT_V
#undef G_WAIT_L
#undef G_BAR
#undef G_SCHED
#undef G_LOAD_GOFF
}

template <int AMODE  , bool F8 = false  >
struct RegSched {
    static constexpr int PID = AMODE; static constexpr bool KJUMP = false, HALFN = false;
    static constexpr bool GATHER = false, FP8 = F8, HALFM = false, BSPLIT = false;
    int nt; long kstepA, kstepB, hstepA, hstepB;
    const char* A; const char* B; long tstepA, tstepB; unsigned pitchA, pitchB;
    int nM, nN, nwg, G, c;
    __device__ __forceinline__ unsigned voffA(int R, int C) const { return AMODE == 0 ? (unsigned)R * pitchA + (unsigned)C * 2u : (unsigned)(C >> 4) * (unsigned)(NTOK * 32) + (unsigned)R * 32u + (unsigned)((C >> 3) & 1) * 16u; }
    __device__ __forceinline__ unsigned voffB(int Rb, int C) const { return (unsigned)Rb * pitchB + (unsigned)C * 2u; }
    __device__ __forceinline__ const LAS unsigned* rowlist(int) const { return nullptr; }
    __device__ __forceinline__ void init(const void* A_, const void* B_, int N, int K, int G_, int c_) {
        constexpr int ES = F8 ? 1 : 2;
        A = (const char*)A_; B = (const char*)B_; nt = K * ES / (BK * 2); nM = NTOK / BM; nN = N / BM; nwg = nM * nN; G = G_; c = c_;
        pitchB = (unsigned)K * ES; kstepB = BK * 2; hstepB = (long)HALF * K * ES; tstepB = 2 * hstepB;
        if (AMODE == 0) { pitchA = (unsigned)K * ES; kstepA = BK * 2; hstepA = (long)HALF * K * ES; tstepA = 2 * hstepA; }
        else { pitchA = 32u; kstepA = 4l * NTOK * 32; hstepA = HALF * 32; tstepA = BM * 32; }
    }
    __device__ __forceinline__ bool next(int i, Unit& u) const {
        const long L = (long)i * G + c; if (L >= nwg) return false;
        int wgid = (int)L; { const int q = nwg / NXCD, r = nwg % NXCD, xcd = wgid % NXCD, off = wgid / NXCD; wgid = (xcd < r ? xcd * (q + 1) : r * (q + 1) + (xcd - r) * q) + off; }
        const int nig = WGM * nN, gid = wgid / nig, fm = gid * WGM, gsz = (nM - fm) < WGM ? (nM - fm) : WGM;
        const int pm = fm + ((wgid % nig) % gsz), pn = (wgid % nig) / gsz;
        u.A = A + (long)pm * tstepA; u.B = B + (long)pn * tstepB; u.p0 = pm; u.p1 = pn; u.p2 = 0; u.p3 = 0; return true;
    }
};
template <int MODE>
struct SsmSched {
    static constexpr int PID = 2 + MODE; static constexpr bool KJUMP = (MODE == 1), HALFN = (MODE == 0);
    static constexpr bool GATHER = false, FP8 = false, HALFM = false, BSPLIT = (MODE == 1);
    int nt; long kstepA, kstepB, hstepA, hstepB, hstepB2;
    const char* A; const char* B; const char* B2s; int G, vcu, lim;
    __device__ __forceinline__ unsigned voffA(int R, int C) const { return (unsigned)R * (UPITCH * 2) + (unsigned)C * 2u; }
    __device__ __forceinline__ unsigned voffB(int Rb, int C) const { return MODE == 0 ? (unsigned)Rb * 1024u + (unsigned)C * 2u : (unsigned)(Rb & 15) * 2048u + (unsigned)(7 - (Rb >> 4)) * 32u + (unsigned)C * 2u; }
    __device__ __forceinline__ unsigned voffB2(int Rb, int C) const { return (unsigned)Rb * 256u + (unsigned)C * 2u; }
    __device__ __forceinline__ const LAS unsigned* rowlist(int) const { return nullptr; }
    __device__ __forceinline__ void init(const void* A_, const void* B_, int G_, int vcu_) {
        A = (const char*)A_; B = (const char*)B_; B2s = nullptr; G = G_; vcu = vcu_; lim = 1 << 20; kstepA = 128; kstepB = 128; hstepA = 128l * UPITCH * 2; hstepB2 = 128l * 256;
        if (MODE == 0) { nt = 8; hstepB = 0; } else { nt = 10; hstepB = -256; }
    }
    __device__ __forceinline__ bool next(int i, Unit& u) const {
        const int L = i * G + vcu;
        if (i >= lim) return false;
        if (MODE == 0) { if (L >= NGRP * 4) return false; const int g = L >> 2, pm = L & 3;
            u.A = A + ((long)g * NCH + pm * 256) * (UPITCH * 2); u.B = B + (long)g * (128 * 1024); u.p0 = g; u.p1 = pm; u.p2 = 0; u.p3 = 0; return true; }
        if (L >= NGRP * 8) return false; const int g = L >> 3, pm = (L >> 1) & 3, pn = (L ^ i) & 1;
        u.A = A + ((long)g * NCH + pm * 256) * (UPITCH * 2); u.B = B + (long)g * (16 * 2048) + (24 - 16 * pn) * 32; u.B2 = B2s + ((long)g * 512 + pn * 256) * 256l; u.p0 = g; u.p1 = pm; u.p2 = pn; u.p3 = 0;
        u.nt = pn == 0 ? 6 : 10; u.kjump = pn == 0 ? 4 : 0; return true;
    }
};
struct UnitRec { int e, rt, tg, pn; };
template <int MODE>
struct MoeSched {
    static constexpr int PID = 4 + MODE; static constexpr bool KJUMP = false, HALFN = false;
    static constexpr bool GATHER = (MODE == 0), FP8 = true, HALFM = true, BSPLIT = false;
    int nt; long kstepA, kstepB, hstepA, hstepB;
    const char* A; const char* B; const LAS UnitRec* ut; const LAS unsigned* lists; int nunits;
    __device__ __forceinline__ unsigned voffA(int R, int C) const { return (unsigned)R * 512u + (unsigned)C * 2u; }
    __device__ __forceinline__ unsigned voffB(int Rb, int C) const { return (unsigned)Rb * (MODE == 0 ? 1024u : 512u) + (unsigned)C * 2u; }
    __device__ __forceinline__ const LAS unsigned* rowlist(int ui) const { return lists + ui * 512; }
    __device__ __forceinline__ void init(const void* A_, const void* B_, const LAS UnitRec* ut_, const LAS unsigned* lists_, int nunits_) {
        A = (const char*)A_; B = (const char*)B_; ut = ut_; lists = lists_; nunits = nunits_; kstepA = 128; kstepB = 128;
        if (MODE == 0) { nt = 8; hstepA = 0; hstepB = 128l * 1024; } else { nt = 4; hstepA = 128l * 512; hstepB = 128l * 512; }
    }
    __device__ __forceinline__ bool next(int i, Unit& u) const {
        if (i >= nunits) return false;
        const int e = __builtin_amdgcn_readfirstlane(ut[i].e), tg = __builtin_amdgcn_readfirstlane(ut[i].tg), pnh = __builtin_amdgcn_readfirstlane(ut[i].pn), pn = pnh & 255, hm = pnh >> 8;
        if (MODE == 0) { u.A = A; u.B = B + ((long)e * 4 + pn) * (256l * 1024); }
        else { u.A = A + ((long)tg * 256 + (hm == 2 ? 128 : 0)) * 512l; u.B = B + ((long)e * 1024 + pn * 256) * 512l; }
        u.p0 = tg; u.p1 = pn; u.p2 = i; u.p3 = e; u.hm = hm; return true;
    }
};

typedef f32x4 AccT[2][2][4][2];
#define EPI_LOOP_AIM for (int ai = 0; ai < 2; ++ai) _Pragma("unroll") for (int m = 0; m < 4; ++m)
struct EpiInproj { static constexpr bool NOTIDEM = false; static constexpr bool PERM = true, PERM2 = false; bf16* UG;
    __device__ __forceinline__ void operator()(const AccT& acc, const Unit& u, int wr, int wc, int fr, int fq) const {
#pragma unroll
        EPI_LOOP_AIM { const int tok = u.p0 * 256 + ai * 128 + wr * 64 + m * 16 + fr;
#pragma unroll
            for (int bj = 0; bj < 2; ++bj) { const int g = u.p1 * 16 + bj * 8 + wc * 2 + (fq >> 1);
                bf16* dst = UG + ((size_t)g * NCH + (tok >> 5)) * UPITCH + (tok & 31) * 16 + (fq & 1) * 8;
                const f32x4 v0 = acc[ai][bj][m][0], v1 = acc[ai][bj][m][1];
                v4u w; w.x = cvt_pk_bf16(v0[0], v0[1]); w.y = cvt_pk_bf16(v0[2], v0[3]); w.z = cvt_pk_bf16(v1[0], v1[1]); w.w = cvt_pk_bf16(v1[2], v1[3]); *(v4u*)dst = w; } }
    } };
struct EpiS1 { static constexpr bool NOTIDEM = false; static constexpr bool PERM = true, PERM2 = false; bf16* SB;
    __device__ __forceinline__ void operator()(const AccT& acc, const Unit& u, int wr, int wc, int fr, int fq) const {
#pragma unroll
        EPI_LOOP_AIM { const int row = u.p1 * 256 + ai * 128 + wr * 64 + m * 16 + fr; bf16* dst = SB + ((size_t)u.p0 * NCH + row) * 128 + wc * 32 + 8 * fq;
            const f32x4 v0 = acc[ai][0][m][0], v1 = acc[ai][0][m][1];
            v4u w; w.x = cvt_pk_bf16(v0[0], v0[1]); w.y = cvt_pk_bf16(v0[2], v0[3]); w.z = cvt_pk_bf16(v1[0], v1[1]); w.w = cvt_pk_bf16(v1[2], v1[3]); *(v4u*)dst = w; }
    } };
struct EpiY { static constexpr bool NOTIDEM = false; static constexpr bool PERM = true, PERM2 = false; bf16* GG;
    __device__ __forceinline__ void operator()(const AccT& acc, const Unit& u, int wr, int wc, int fr, int fq) const {
#pragma unroll
        EPI_LOOP_AIM { const int row = u.p1 * 256 + ai * 128 + wr * 64 + m * 16 + fr; bf16* dst = GG + ((size_t)u.p0 * NCH + row) * 512 + u.p2 * 256 + wc * 32 + 8 * fq;
#pragma unroll
            for (int bj = 0; bj < 2; ++bj) { const f32x4 v0 = acc[ai][bj][m][0], v1 = acc[ai][bj][m][1];
                v4u w; w.x = cvt_pk_bf16(gelu_tanh(v0[0]), gelu_tanh(v0[1])); w.y = cvt_pk_bf16(gelu_tanh(v0[2]), gelu_tanh(v0[3]));
                w.z = cvt_pk_bf16(gelu_tanh(v1[0]), gelu_tanh(v1[1])); w.w = cvt_pk_bf16(gelu_tanh(v1[2]), gelu_tanh(v1[3])); *(v4u*)(dst + bj * 128) = w; } }
    } };
struct EpiGlu { static constexpr bool PERM = true, PERM2 = false; const float* X0; bf16* XO; const float* gate1;
    __device__ __forceinline__ void operator()(const AccT& acc, const Unit& u, int wr, int wc, int fr, int fq) const {
        const int b = u.p0 >> 6, col0 = u.p1 * 128 + wc * 32 + 8 * fq;
        const size_t off0 = (size_t)(u.p0 * 256 + wr * 64 + fr) * D + col0;
        f32x4 xv[2][4][2];
#pragma unroll
        for (int ai = 0; ai < 2; ++ai)
#pragma unroll
            for (int m = 0; m < 4; ++m)
#pragma unroll
                for (int n = 0; n < 2; ++n) xv[ai][m][n] = __builtin_nontemporal_load((const f32x4*)(X0 + off0 + (size_t)(ai * 128 + m * 16) * D + n * 4));
        f32x4 gv[2];
#pragma unroll
        for (int n = 0; n < 2; ++n) { gv[n] = *(const f32x4*)(gate1 + b * 6144 + col0 + n * 4); gv[n] = gv[n] + 1.0f; }
#pragma unroll
        EPI_LOOP_AIM { float o[8];
#pragma unroll
            for (int n = 0; n < 2; ++n) { const f32x4 va = acc[ai][0][m][n], ga = acc[ai][1][m][n];
#pragma unroll
                for (int j = 0; j < 4; ++j) o[n * 4 + j] = xv[ai][m][n][j] + gv[n][j] * va[j] * sigmoidf_(ga[j]); }
            v4u w; w.x = cvt_pk_bf16(o[0], o[1]); w.y = cvt_pk_bf16(o[2], o[3]); w.z = cvt_pk_bf16(o[4], o[5]); w.w = cvt_pk_bf16(o[6], o[7]);
            *(v4u*)(XO + off0 + (size_t)(ai * 128 + m * 16) * D) = w; }
    } };
struct EpiCV { static constexpr bool NOTIDEM = false; static constexpr bool PERM = true, PERM2 = false; bf16* UU;
    __device__ __forceinline__ void operator()(const AccT& acc, const Unit& u, int wr, int wc, int fr, int fq) const {
#pragma unroll
        EPI_LOOP_AIM { bf16* dst = UU + (size_t)(u.p0 * 256 + ai * 128 + wr * 64 + m * 16 + fr) * D + u.p1 * 128 + wc * 32 + 8 * fq;
            const f32x4 c0 = acc[ai][0][m][0], c1 = acc[ai][0][m][1], v0 = acc[ai][1][m][0], v1 = acc[ai][1][m][1];
            v4u w; w.x = cvt_pk_bf16(c0[0] * v0[0], c0[1] * v0[1]); w.y = cvt_pk_bf16(c0[2] * v0[2], c0[3] * v0[3]); w.z = cvt_pk_bf16(c1[0] * v1[0], c1[1] * v1[1]); w.w = cvt_pk_bf16(c1[2] * v1[2], c1[3] * v1[3]);
            *(v4u*)dst = w; }
    } };
struct EpiBf16 { static constexpr bool NOTIDEM = false; static constexpr bool PERM = true, PERM2 = false; bf16* O; int ldc;
    __device__ __forceinline__ void operator()(const AccT& acc, const Unit& u, int wr, int wc, int fr, int fq) const {
#pragma unroll
        EPI_LOOP_AIM { bf16* dst = O + (size_t)(u.p0 * 256 + ai * 128 + wr * 64 + m * 16 + fr) * ldc + u.p1 * 256 + wc * 32 + 8 * fq;
#pragma unroll
            for (int bj = 0; bj < 2; ++bj) { const f32x4 v0 = acc[ai][bj][m][0], v1 = acc[ai][bj][m][1];
                v4u w; w.x = cvt_pk_bf16(v0[0], v0[1]); w.y = cvt_pk_bf16(v0[2], v0[3]); w.z = cvt_pk_bf16(v1[0], v1[1]); w.w = cvt_pk_bf16(v1[2], v1[3]); *(v4u*)(dst + bj * 128) = w; } }
    } };
struct EpiResid { static constexpr bool PERM = true, PERM2 = false; bf16* X; const float* gate1;
    __device__ __forceinline__ void operator()(const AccT& acc, const Unit& u, int wr, int wc, int fr, int fq) const {
        const int b = u.p0 >> 6, col0 = u.p1 * 256 + wc * 32 + 8 * fq;
        bf16* base = X + (size_t)(u.p0 * 256 + wr * 64 + fr) * D + col0;
        f32x4 gv[2][2];
#pragma unroll
        for (int bj = 0; bj < 2; ++bj)
#pragma unroll
            for (int n = 0; n < 2; ++n) { gv[bj][n] = *(const f32x4*)(gate1 + b * 6144 + col0 + bj * 128 + n * 4); gv[bj][n] = (gv[bj][n] + 1.0f) * (1.0f / (FS_A3 * FS_WCO)); }
#pragma unroll
        for (int ai = 0; ai < 2; ++ai) {
            v4u xq[4][2];
#pragma unroll
            for (int m = 0; m < 4; ++m)
#pragma unroll
                for (int bj = 0; bj < 2; ++bj) xq[m][bj] = *(const v4u*)(base + (size_t)(ai * 128 + m * 16) * D + bj * 128);
#pragma unroll
            for (int m = 0; m < 4; ++m) { bf16* rowp = base + (size_t)(ai * 128 + m * 16) * D;
#pragma unroll
                for (int bj = 0; bj < 2; ++bj) { const v4u q = xq[m][bj]; const f32x4 a0 = acc[ai][bj][m][0], a1 = acc[ai][bj][m][1];
                    v4u w; w.x = cvt_pk_bf16(bf_lo(q.x) + gv[bj][0][0] * a0[0], bf_hi(q.x) + gv[bj][0][1] * a0[1]); w.y = cvt_pk_bf16(bf_lo(q.y) + gv[bj][0][2] * a0[2], bf_hi(q.y) + gv[bj][0][3] * a0[3]);
                    w.z = cvt_pk_bf16(bf_lo(q.z) + gv[bj][1][0] * a1[0], bf_hi(q.z) + gv[bj][1][1] * a1[1]); w.w = cvt_pk_bf16(bf_lo(q.w) + gv[bj][1][2] * a1[2], bf_hi(q.w) + gv[bj][1][3] * a1[3]);
                    *(v4u*)(rowp + bj * 128) = w; } }
            asm volatile("" ::: "memory"); }
    } };
struct EpiMoe1 { static constexpr bool NOTIDEM = false; static constexpr bool PERM = true, PERM2 = false; unsigned char* HB;
    __device__ __forceinline__ void operator()(const AccT& acc, const Unit& u, int wr, int wc, int fr, int fq) const {
        constexpr float IA = 1.0f / (FS_XN * FS_W13), IB = FS_H / (FS_XN * FS_W13);
        const int roff = u.hm == 2 ? 128 : 0;
#pragma unroll
        for (int ai = 0; ai < 2; ++ai) if (!(ai && u.hm)) _Pragma("unroll") for (int mp = 0; mp < 2; ++mp) { v2u w[2];
#pragma unroll
            for (int q = 0; q < 2; ++q) { const int m = 2 * mp + q;
                const f32x4 a0 = acc[ai][0][m][0] * IA, a1 = acc[ai][0][m][1] * IA, b0 = acc[ai][1][m][0] * IB, b1 = acc[ai][1][m][1] * IB; float h[8];
#pragma unroll
                for (int j = 0; j < 4; ++j) { h[j] = sat_fp8(a0[j] * sigmoidf_(a0[j]) * b0[j]); h[4 + j] = sat_fp8(a1[j] * sigmoidf_(a1[j]) * b1[j]); }
                w[q].x = pk4_fp8(h[0], h[1], h[2], h[3]); w[q].y = pk4_fp8(h[4], h[5], h[6], h[7]); }
            const v2u r0 = __builtin_amdgcn_permlane16_swap(w[0].x, w[1].x, false, false), r1 = __builtin_amdgcn_permlane16_swap(w[0].y, w[1].y, false, false);
            const int m = 2 * mp + (fq & 1);
            unsigned char* dst = HB + ((size_t)u.p0 * 256 + roff + ai * 128 + wr * 64 + m * 16 + fr) * DEXP + u.p1 * 128 + wc * 32 + 8 * (fq & 2);
            v4u o; o.x = r0.x; o.y = r1.x; o.z = r0.y; o.w = r1.y; *(v4u*)dst = o; }
    } };
struct EpiMoe2 { static constexpr bool NOTIDEM = false; static constexpr bool PERM = true, PERM2 = true; unsigned char* O2; const LAS unsigned* lists;
    __device__ __forceinline__ void operator()(const AccT& acc, const Unit& u, int wr, int wc, int fr, int fq) const {
        const LAS unsigned* sl = lists + u.p2 * 512;
        const int fr_ = fresh_lane() & 15;
        const int roff = u.hm == 2 ? 128 : 0;
#pragma unroll
        for (int ai = 0; ai < 2; ++ai) if (!(ai && u.hm)) _Pragma("unroll") for (int m = 0; m < 4; ++m) { const int r = roff + ai * 128 + wr * 64 + m * 16 + fr_; const unsigned slot = sl[r]; const float wt = __builtin_bit_cast(float, sl[256 + r]) * (FS_O / (FS_H * FS_W2));
            if (slot != 0xffffffffu) { unsigned char* dst = O2 + (size_t)slot * D + u.p1 * 256 + wc * 64 + 16 * fq; unsigned w4[4];
#pragma unroll
                for (int bj = 0; bj < 2; ++bj)
#pragma unroll
                    for (int n = 0; n < 2; ++n) { const f32x4 v = acc[ai][bj][m][n] * wt; w4[bj * 2 + n] = pk4_fp8(sat_fp8(v[0]), sat_fp8(v[1]), sat_fp8(v[2]), sat_fp8(v[3])); }
                v4u w; w.x = w4[0]; w.y = w4[1]; w.z = w4[2]; w.w = w4[3]; *(v4u*)dst = w; } }
    } };
}

enum { I_X = 0, I_C, I_ADAW, I_ADAB, I_N1G, I_N2G, I_SWIN, I_LRE, I_LIM, I_LDT, I_BRE, I_BIM, I_CRE, I_CIM, I_SD, I_SWGLU, I_CWIN, I_CW, I_CWOUT, I_WG, I_BGB, I_WE, I_BEB, I_W1, I_W3, I_W2, I_FG };
constexpr int NPH = 18;

template <bool FP8 = false, class RowPtr>
__device__ __forceinline__ void transpose_item(const float* W, int ldw, int k0, int n0, RowPtr rp, LAS float* scr, int lane, float fs = 1.0f) {
    float v[64];
    const float* src = W + (size_t)k0 * ldw + n0 + lane;
#pragma unroll
    for (int i = 0; i < 64; ++i) v[i] = __builtin_nontemporal_load(src + (size_t)i * ldw);
#pragma unroll
    for (int i = 0; i < 64; ++i) scr[i * 65 + lane] = v[i];
    LDS_WAIT(); asm volatile("" ::: "memory");
    const int c = lane & 7;
#pragma unroll
    for (int j = 0; j < 8; ++j) { const int n = (lane >> 3) + 8 * j; const LAS float* s = scr + (8 * c) * 65 + n;
        if constexpr (FP8) { v2u o; o.x = pk4_fp8(s[0 * 65] * fs, s[1 * 65] * fs, s[2 * 65] * fs, s[3 * 65] * fs); o.y = pk4_fp8(s[4 * 65] * fs, s[5 * 65] * fs, s[6 * 65] * fs, s[7 * 65] * fs);
            __builtin_nontemporal_store(o, (v2u*)(rp(n0 + n) + k0 + 8 * c)); }
        else { v4u o; o.x = pk2(s[0 * 65], s[1 * 65]); o.y = pk2(s[2 * 65], s[3 * 65]); o.z = pk2(s[4 * 65], s[5 * 65]); o.w = pk2(s[6 * 65], s[7 * 65]);
            __builtin_nontemporal_store(o, (v4u*)(rp(n0 + n) + k0 + 8 * c)); } }
    LDS_WAIT(); asm volatile("" ::: "memory");
}
constexpr int MOE_WITEMS = 12288;
__device__ __forceinline__ void moe_weight_item(const KArgs a, unsigned char* ws, int id, int le_base, LAS float* scr, int lane) {
    unsigned char* W13 = ws + WS_W13 + (size_t)(le_base >> 5) * (64 * MiB); unsigned char* W2T = ws + WS_W2 + (size_t)(le_base >> 5) * (32 * MiB);
    const int which = id >> 12, r = id & 4095, e = r >> 7, le = le_base + e;
    if (which < 2) { const int kb = (r >> 3) & 15, nb = r & 7;
        transpose_item<true>(a.in(which ? I_W3 : I_W1) + (size_t)le * 1024 * 512, 512, kb * 64, nb * 64, [&](int n) { return W13 + ((size_t)e * 1024 + (n >> 7) * 256 + which * 128 + (n & 127)) * 1024; }, scr, lane, FS_W13); }
    else { const int kb = (r >> 4) & 7, nb = r & 15;
        transpose_item<true>(a.in(I_W2) + (size_t)le * 512 * 1024, 1024, kb * 64, nb * 64, [&](int n) { return W2T + ((size_t)e * 1024 + n) * 512; }, scr, lane, FS_W2); }
}
constexpr int DEF_A = 2048, DEF_QB = 16, DEF_QC = 8;
__device__ __forceinline__ void deferred_items(const KArgs a, LAS unsigned char* lds, int first, int count, int slot, int nslots, int wave) {
    unsigned char* ws = a.ws(); LAS float* scr = (LAS float*)(lds + wave * 16640);
    const int lane = fresh_lane();
    for (int id = first + slot; id < first + count && id < MOE_WITEMS; id += nslots) moe_weight_item(a, ws, id, 32, scr, lane);
}
__device__ __forceinline__ void light_info(int P, int G, int bx, int& L, int& rank) {
    L = 0; rank = -1; if (G != 256) return;
    int nmax = 0;
    for (int x = 0; x < 8; ++x) { const int nx = 4 * (((x + 1) * P) / 8 - (x * P) / 8); const int rem = nx & 31; const int m = 2 * (nx >> 5) + (rem == 0 ? 0 : (rem <= 16 ? 1 : 2)); nmax = m > nmax ? m : nmax; }
    const int mx = bx & 7, mj = bx >> 3;
    for (int x = 0; x < 8; ++x) { const int nx = 4 * (((x + 1) * P) / 8 - (x * P) / 8); const int rem = nx & 31; const int m = 2 * (nx >> 5) + (rem == 0 ? 0 : (rem <= 16 ? 1 : 2));
        const int first_light = (m < nmax) ? 0 : (rem == 0 ? 32 : (rem <= 16 ? 2 * rem : rem));
        if (x == mx && mj >= first_light) rank = L + (mj - first_light);
        L += 32 - first_light; }
}
struct Cplx { float re, im; };
__device__ __forceinline__ Cplx lam_pow(float lr, float li, float dt, int tau) {
    const float mag = expf(lr * dt * (float)tau);
    const double ang = (double)li * (double)dt * (double)tau;
    const double nrev = __builtin_rint(ang * 0.15915494309189535);
    const float r = (float)(ang - nrev * 6.283185307179586);
    Cplx e; e.re = mag * cosf(r); e.im = mag * sinf(r); return e;
}
__device__ __forceinline__ float reduce16(const float (&v)[16], int lane) {
    float a[8], b[4], c[2], d;
    const bool b5 = lane & 32, b4 = lane & 16, b3 = lane & 8, b2 = lane & 4;
#pragma unroll
    for (int i = 0; i < 8; ++i) { const float keep = b5 ? v[2 * i + 1] : v[2 * i], send = b5 ? v[2 * i] : v[2 * i + 1]; a[i] = keep + shx(send, 32, lane); }
#pragma unroll
    for (int i = 0; i < 4; ++i) { const float keep = b4 ? a[2 * i + 1] : a[2 * i], send = b4 ? a[2 * i] : a[2 * i + 1]; b[i] = keep + shx(send, 16, lane); }
#pragma unroll
    for (int i = 0; i < 2; ++i) { const float keep = b3 ? b[2 * i + 1] : b[2 * i], send = b3 ? b[2 * i] : b[2 * i + 1]; c[i] = keep + shx(send, 8, lane); }
    { const float keep = b2 ? c[1] : c[0], send = b2 ? c[0] : c[1]; d = keep + shx(send, 4, lane); }
    d += shx(d, 2, lane); d += shx(d, 1, lane);
    return d;
}

__device__ __forceinline__ void p0_prologue(const KArgs a, LAS unsigned char* lds, int vcu, int G, int tid, int lane, int wave) {
    unsigned char* ws = a.ws();
    asm volatile("" : "+v"(tid)); lane = tid & 63;
    {
        LAS float* cond = (LAS float*)lds; LAS float* part = cond + 2048;
        __syncthreads();
        for (int i = tid; i < 2048; i += 512) { const float c = a.in(I_C)[i]; cond[i] = c / (1.0f + expf(-c)); }
        __syncthreads();
        float* mod = (float*)(ws + WS_MOD);
        for (int task = vcu; task < 256; task += G) {
            const int l = task >> 7, nb = task & 127;
            const float* W = a.in(I_ADAW) + (size_t)l * 1024 * 6144 + nb * 48 + (lane < 48 ? lane : 0);
            float a0 = 0.f, a1 = 0.f;
#pragma unroll 32
            for (int k = wave * 128; k < wave * 128 + 128; ++k) { const float w = __builtin_nontemporal_load(W + (size_t)k * 6144); a0 += cond[k] * w; a1 += cond[1024 + k] * w; }
            if (lane < 48) { part[(wave * 2 + 0) * 48 + lane] = a0; part[(wave * 2 + 1) * 48 + lane] = a1; }
            __syncthreads();
            if (tid < 96) { const int b = tid / 48, j = tid % 48; float s = 0.f;
#pragma unroll
                for (int w = 0; w < 8; ++w) s += part[(w * 2 + b) * 48 + j];
                const int n = nb * 48 + j; mod[(l * 2 + b) * 6144 + n] = s + a.in(I_ADAB)[l * 6144 + n]; }
            __syncthreads();
        }
    }
    LAS float* scr = (LAS float*)(lds + wave * 16640);
    const int gw = vcu * NWAVES + wave, NGW = G * NWAVES;
    bf16* WIN = (bf16*)(ws + WS_WIN); bf16* WGLU = (bf16*)(ws + WS_WGLU); bf16* WCIN = (bf16*)(ws + WS_WCIN); bf16* WCOUT = (bf16*)(ws + WS_WCOUT);
    bf16* BM_ = (bf16*)(ws + WS_BM); bf16* BT = (bf16*)(ws + WS_BT); bf16* CM_ = (bf16*)(ws + WS_CM); float* SC = (float*)(ws + WS_SC);
    constexpr int I0 = 256, I1 = 512, I2 = 768, I3 = 256, I4 = MOE_WITEMS, I7 = NGRP * 63, I8 = NGRP * 32, I9 = NGRP * 32, I10 = NGRP, I11 = 96;
    constexpr int NITEMS = I0 + I1 + I2 + I3 + I4 + I7 + I8 + I9 + I10 + I11;
    for (int it = gw; it < NITEMS; it += NGW) {
        int r = it;
        if (r < I0) { const int kb = r >> 4, nb = r & 15; transpose_item(a.in(I_SWIN), 1024, kb * 64, nb * 64, [&](int n) { return WIN + (size_t)n * 1024; }, scr, lane); continue; } r -= I0;
        if (r < I1) { const int kb = r >> 5, nb = r & 31;
            transpose_item(a.in(I_SWGLU), 2048, kb * 64, nb * 64, [&](int n) { const int half = n >> 10, nn = n & 1023; return WGLU + (size_t)((nn >> 7) * 256 + half * 128 + (nn & 127)) * 1024; }, scr, lane); continue; } r -= I1;
        if (r < I2) { const int kb = r / 48, nb = r % 48;
            transpose_item(a.in(I_CWIN), 3072, kb * 64, nb * 64, [&](int n) { const int part = n >> 10, nn = n & 1023;
                const int row = part == 0 ? 2048 + nn : (nn >> 7) * 256 + (part - 1) * 128 + (nn & 127); return WCIN + (size_t)row * 1024; }, scr, lane); continue; } r -= I2;
        if (r < I3) { const int kb = r >> 4, nb = r & 15; transpose_item<true>(a.in(I_CWOUT), 1024, kb * 64, nb * 64, [&](int n) { return (unsigned char*)WCOUT + (size_t)n * 1024; }, scr, lane, FS_WCO); continue; } r -= I3;
        if (r < I4) { moe_weight_item(a, ws, r, 0, scr, lane); continue; } r -= I4;
        if (r >= I7 + I8 + I9 + I10) {
            r -= I7 + I8 + I9 + I10; const int l = r / 48, n = r % 48; bf16* hrow = (bf16*)(ws + WS_WR) + ((size_t)(l * 2) * 48 + n) * 1024; bf16* lrow = hrow + 48 * 1024;
            for (int i = 0; i < 16; ++i) { const int k = lane + 64 * i; const float w = n < 4 ? a.in(I_WG)[((size_t)l * 1024 + k) * 4 + n] : (n < 36 ? a.in(I_WE)[((size_t)l * 1024 + k) * 32 + n - 4] : 0.f);
                const unsigned hb = f2bf(w); hrow[k] = (bf16)hb; lrow[k] = (bf16)f2bf(w - __builtin_bit_cast(float, hb << 16)); }
            continue; }
        int g, sub, kind;
        if (r < I7) { kind = 0; g = r / 63; sub = r % 63 - 31; } else { r -= I7; if (r < I8) { kind = 1; g = r >> 5; sub = r & 31; } else { r -= I8; if (r < I9) { kind = 2; g = r >> 5; sub = r & 31; } else { r -= I9; kind = 3; g = r; sub = 0; } } }
        const int p = lane;
        float crv[16], civ[16];
        if (kind == 0 && sub >= 0) {
#pragma unroll
            for (int s = 0; s < 16; ++s) { crv[s] = a.in(I_CRE)[(g * 16 + (lane & 15)) * 64 + 4 * s + (lane >> 4)]; civ[s] = a.in(I_CIM)[(g * 16 + (lane & 15)) * 64 + 4 * s + (lane >> 4)]; } }
        else if (kind == 1) {
#pragma unroll
            for (int k = 0; k < 16; ++k) { crv[k] = a.in(I_CRE)[(g * 16 + k) * 64 + p]; civ[k] = a.in(I_CIM)[(g * 16 + k) * 64 + p]; } }
        else {
#pragma unroll
            for (int k = 0; k < 16; ++k) { crv[k] = 0.f; civ[k] = 0.f; } }
        const float lr = a.in(I_LRE)[g * 64 + p], li = a.in(I_LIM)[g * 64 + p], dt = expf(a.in(I_LDT)[g]);
        if (kind == 3) { const Cplx e = lam_pow(lr, li, dt, LC); SC[(g * 64 + p) * 2] = e.re; SC[(g * 64 + p) * 2 + 1] = e.im; continue; }
        if (kind == 1) {
            const Cplx e = lam_pow(lr, li, dt, sub + 1);
#pragma unroll
            for (int k = 0; k < 16; ++k) { const float cr = crv[k], ci = civ[k];
                bf16* row = CM_ + ((size_t)g * 512 + sub * 16 + k) * 128; row[p] = (bf16)f2bf(cr * e.re - ci * e.im); row[64 + p] = (bf16)f2bf(-(cr * e.im + ci * e.re)); }
            continue; }
        const Cplx ab = lam_pow(lr, li, dt, 1);
        const float den = lr * lr + li * li, cfr = ((ab.re - 1.0f) * lr + ab.im * li) / den, cfi = (ab.im * lr - (ab.re - 1.0f) * li) / den;
        if (kind == 0 && sub < 0) {
            if (lane < 32) { const int k = (lane >> 1) & 15, half = lane & 1; *(v4u*)(BT + ((size_t)g * 16 + k) * 1024 + (31 - sub) * 16 + half * 8) = (v4u){0u, 0u, 0u, 0u}; }
            continue; }
        const Cplx e = lam_pow(lr, li, dt, kind == 0 ? sub : (LC - 1 - sub));
        float wre[16], wim[16];
        { const f32x4* brp = (const f32x4*)(a.in(I_BRE) + (size_t)(g * 64 + p) * 16); const f32x4* bip = (const f32x4*)(a.in(I_BIM) + (size_t)(g * 64 + p) * 16);
#pragma unroll
            for (int q = 0; q < 4; ++q) { const f32x4 br = brp[q], bi = bip[q];
#pragma unroll
                for (int j = 0; j < 4; ++j) { const float bbr = cfr * br[j] - cfi * bi[j], bbi = cfr * bi[j] + cfi * br[j]; wre[q * 4 + j] = e.re * bbr - e.im * bbi; wim[q * 4 + j] = e.re * bbi + e.im * bbr; } } }
        if (kind == 2) {
            bf16* r0 = BM_ + ((size_t)g * 128 + p) * 512 + sub * 16; bf16* r1 = r0 + 64 * 512;
            v4u o; o.x = pk2(wre[0], wre[1]); o.y = pk2(wre[2], wre[3]); o.z = pk2(wre[4], wre[5]); o.w = pk2(wre[6], wre[7]); *(v4u*)r0 = o;
            o.x = pk2(wre[8], wre[9]); o.y = pk2(wre[10], wre[11]); o.z = pk2(wre[12], wre[13]); o.w = pk2(wre[14], wre[15]); *(v4u*)(r0 + 8) = o;
            o.x = pk2(wim[0], wim[1]); o.y = pk2(wim[2], wim[3]); o.z = pk2(wim[4], wim[5]); o.w = pk2(wim[6], wim[7]); *(v4u*)r1 = o;
            o.x = pk2(wim[8], wim[9]); o.y = pk2(wim[10], wim[11]); o.z = pk2(wim[12], wim[13]); o.w = pk2(wim[14], wim[15]); *(v4u*)(r1 + 8) = o;
            continue; }
        {
#pragma unroll
            for (int q = 0; q < 4; ++q) { *(LAS f32x4*)(scr + p * 16 + 4 * q) = (f32x4){wre[4 * q], wre[4 * q + 1], wre[4 * q + 2], wre[4 * q + 3]};
                *(LAS f32x4*)(scr + 1024 + p * 16 + 4 * q) = (f32x4){wim[4 * q], wim[4 * q + 1], wim[4 * q + 2], wim[4 * q + 3]}; }
            LDS_WAIT(); asm volatile("" ::: "memory");
            const int kq = lane & 15, pq = lane >> 4;
            f32x4 acc = (f32x4){0.f, 0.f, 0.f, 0.f};
#pragma unroll
            for (int s = 0; s < 16; ++s) { const float wr = scr[(4 * s + pq) * 16 + kq], wi = scr[1024 + (4 * s + pq) * 16 + kq];
                acc = __builtin_amdgcn_mfma_f32_16x16x4f32(crv[s], wr, acc, 0, 0, 0); acc = __builtin_amdgcn_mfma_f32_16x16x4f32(-civ[s], wi, acc, 0, 0, 0); }
#pragma unroll
            for (int r_ = 0; r_ < 4; ++r_) { const int k = 4 * pq + r_; float m = acc[r_]; if (sub == 0 && k == kq) m += a.in(I_SD)[g * 16 + k];
                BT[((size_t)g * 16 + k) * 1024 + (31 - sub) * 16 + kq] = (bf16)f2bf(m); }
            LDS_WAIT(); asm volatile("" ::: "memory");
        }
    }
}

__device__ __forceinline__ void unpack8(const v4u q, float (&f)[8]) { f[0] = bf_lo(q.x); f[1] = bf_hi(q.x); f[2] = bf_lo(q.y); f[3] = bf_hi(q.y); f[4] = bf_lo(q.z); f[5] = bf_hi(q.z); f[6] = bf_lo(q.w); f[7] = bf_hi(q.w); }
__device__ __forceinline__ v4u pack8(const float (&f)[8]) { v4u o; o.x = pk2(f[0], f[1]); o.y = pk2(f[2], f[3]); o.z = pk2(f[4], f[5]); o.w = pk2(f[6], f[7]); return o; }
template <bool COMBINE, bool FINAL, bool XF32  >
__device__ __forceinline__ void norm_phase(const KArgs a, LAS unsigned char* lds, int vcu, int G, int tid, int lane, int wave,
                                           const void* xin, bf16* xio, float* outf, const float* gain, const float* modl  , int sh_idx  ,
                                           const float* modprev  ) {
    unsigned char* ws = a.ws();
    asm volatile("" : "+v"(tid)); lane = tid & 63;
    bf16* XN = (bf16*)(ws + WS_XN); const unsigned char* O2 = ws + WS_O2;
    constexpr int RPI = (COMBINE || XF32) ? 2 : 4, NIT = 16 / RPI;
    for (int blk = vcu; blk < NTOK / 128; blk += G) {
        const int b = (blk * 128) >> 14;
        float gmv[2][8], shv[2][8], ggv[2][8];
#pragma unroll
        for (int j = 0; j < 2; ++j)
#pragma unroll
            for (int h = 0; h < 2; ++h) { const int c = 512 * j + 8 * lane + 4 * h; const f32x4 gn = *(const f32x4*)(gain + c); f32x4 gmq, shq;
                if constexpr (FINAL) { gmq = gn; shq = (f32x4){0.f, 0.f, 0.f, 0.f}; }
                else { const f32x4 sc = *(const f32x4*)(modl + b * 6144 + (sh_idx + 1) * 1024 + c); gmq = gn * (sc + 1.0f); shq = *(const f32x4*)(modl + b * 6144 + sh_idx * 1024 + c); }
#pragma unroll
                for (int q = 0; q < 4; ++q) { gmv[j][4 * h + q] = gmq[q]; shv[j][4 * h + q] = shq[q]; }
                if constexpr (COMBINE) { const f32x4 gq = (*(const f32x4*)(modprev + b * 6144 + 5 * 1024 + c) + 1.0f) * (1.0f / FS_O);
#pragma unroll
                    for (int q = 0; q < 4; ++q) ggv[j][4 * h + q] = gq[q]; } }
        typedef typename std::conditional<XF32, f32x4, v4u>::type XRaw; constexpr int XP = XF32 ? 2 : 1;
        XRaw rx[RPI][2][XP], nx[RPI][2][XP]; v2u ro0[COMBINE ? RPI : 1][2], ro1[COMBINE ? RPI : 1][2], no0[COMBINE ? RPI : 1][2], no1[COMBINE ? RPI : 1][2];
#define NORM_LOAD(dx, d0, d1, mbase) do { _Pragma("unroll") for (int rr = 0; rr < RPI; ++rr) _Pragma("unroll") for (int j = 0; j < 2; ++j) { const size_t m_ = (size_t)((mbase) + rr); \
            if constexpr (XF32) { dx[rr][j][0] = __builtin_nontemporal_load((const XRaw*)((const float*)xin + m_ * D + 512 * j + 8 * lane)); dx[rr][j][XP - 1] = __builtin_nontemporal_load((const XRaw*)((const float*)xin + m_ * D + 512 * j + 8 * lane + 4)); } \
            else { if constexpr (FINAL) dx[rr][j][0] = __builtin_nontemporal_load((const XRaw*)((const bf16*)xin + m_ * D + 512 * j + 8 * lane)); else dx[rr][j][0] = *(const XRaw*)((const bf16*)xin + m_ * D + 512 * j + 8 * lane); } \
            if constexpr (COMBINE) { d0[rr][j] = __builtin_nontemporal_load((const v2u*)(O2 + (2 * m_) * D + 512 * j + 8 * lane)); d1[rr][j] = __builtin_nontemporal_load((const v2u*)(O2 + (2 * m_ + 1) * D + 512 * j + 8 * lane)); } } } while (0)
        NORM_LOAD(rx, ro0, ro1, blk * 128 + wave * 16);
        for (int it = 0; it < NIT; ++it) {
            const int m0 = blk * 128 + wave * 16 + RPI * it;
            if (it + 1 < NIT) NORM_LOAD(nx, no0, no1, m0 + RPI);
#pragma unroll
            for (int rr = 0; rr < RPI; ++rr) { const size_t m = (size_t)(m0 + rr); float h[2][8]; float ss = 0.f;
#pragma unroll
                for (int j = 0; j < 2; ++j) {
                    if constexpr (XF32) {
#pragma unroll
                        for (int q = 0; q < 4; ++q) { h[j][q] = rx[rr][j][0][q]; h[j][4 + q] = rx[rr][j][XP - 1][q]; } }
                    else unpack8(__builtin_bit_cast(v4u, rx[rr][j][0]), h[j]);
                    if constexpr (COMBINE) { float p0[8], p1[8]; unpack8_fp8(ro0[rr][j], p0); unpack8_fp8(ro1[rr][j], p1);
#pragma unroll
                        for (int q = 0; q < 8; ++q) h[j][q] += ggv[j][q] * (p0[q] + p1[q]);
                        if constexpr (!FINAL) *(v4u*)(xio + m * D + 512 * j + 8 * lane) = pack8(h[j]); }
#pragma unroll
                    for (int q = 0; q < 8; ++q) ss += h[j][q] * h[j][q]; }
                const float rstd = 1.0f / sqrtf(wave_sum(ss, lane) * (1.0f / D) + RMS_EPS);
#pragma unroll
                for (int j = 0; j < 2; ++j) {
#pragma unroll
                    for (int q = 0; q < 8; ++q) h[j][q] = h[j][q] * rstd * gmv[j][q] + shv[j][q];
                    if constexpr (FINAL) { __builtin_nontemporal_store((f32x4){h[j][0], h[j][1], h[j][2], h[j][3]}, (f32x4*)(outf + m * D + 512 * j + 8 * lane)); __builtin_nontemporal_store((f32x4){h[j][4], h[j][5], h[j][6], h[j][7]}, (f32x4*)(outf + m * D + 512 * j + 8 * lane + 4)); }
                    else *(v4u*)(XN + m * D + 512 * j + 8 * lane) = pack8(h[j]); } }
#pragma unroll
            for (int rr = 0; rr < RPI; ++rr)
#pragma unroll
                for (int j = 0; j < 2; ++j) {
#pragma unroll
                    for (int p = 0; p < XP; ++p) rx[rr][j][p] = nx[rr][j][p];
                    if constexpr (COMBINE) { ro0[rr][j] = no0[rr][j]; ro1[rr][j] = no1[rr][j]; } }
        }
#undef NORM_LOAD
    }
}

__device__ __forceinline__ void router_fold_row(const KArgs a, int row, int lane) {
    unsigned char* ws = a.ws();
    const int l = row / 96, b = (row / 48) & 1, n = row % 48;
    const bf16* wh = (const bf16*)(ws + WS_WR) + ((size_t)(l * 2) * 48 + n) * 1024 + lane * 16; const bf16* wl = wh + 48 * 1024;
    const float* gain = a.in(I_N2G) + l * 1024 + lane * 16; const float* md = (const float*)(ws + WS_MOD) + (size_t)(l * 2 + b) * 6144 + lane * 16;
    float acc = 0.f; unsigned o[8];
#pragma unroll
    for (int h = 0; h < 2; ++h) { float wv[8], lv[8]; unpack8(*(const v4u*)(wh + 8 * h), wv); unpack8(*(const v4u*)(wl + 8 * h), lv);
#pragma unroll
        for (int q = 0; q < 8; ++q) { const float w = wv[q] + lv[q]; acc += md[3 * 1024 + 8 * h + q] * w; wv[q] = w * gain[8 * h + q] * (1.0f + md[4 * 1024 + 8 * h + q]); }
#pragma unroll
        for (int q = 0; q < 4; ++q) o[4 * h + q] = pk2(wv[2 * q], wv[2 * q + 1]); }
    bf16* dst = (bf16*)(ws + WS_WRF) + ((size_t)(l * 2 + b) * 48 + n) * 1024 + lane * 16;
    *(v4u*)dst = (v4u){o[0], o[1], o[2], o[3]}; *(v4u*)(dst + 8) = (v4u){o[4], o[5], o[6], o[7]};
    acc = wave_sum(acc, lane);
    if (lane == 0) ((float*)(ws + WS_RBIAS))[row] = acc + (n < 4 ? a.in(I_BGB)[l * 4 + n] : (n < 36 ? a.in(I_BEB)[l * 32 + n - 4] : 0.f));
}

constexpr int LR_WH = 0, LR_WSTR = 1032, LR_GS = 99072, LR_RST = 107264, LR_LG = 107776;
__device__ __forceinline__ void router_phase(const KArgs a, LAS unsigned char* lds, int vcu, int G, int tid, int lane, int wave, const float* gain, const float* modl, int layer) {
    unsigned char* ws = a.ws();
    asm volatile("" : "+v"(tid)); lane = tid & 63;
    const bf16* XB = (const bf16*)(ws + WS_XB); unsigned char* XN = ws + WS_XN;
    LAS bf16* WH = (LAS bf16*)(lds + LR_WH); LAS float* GS = (LAS float*)(lds + LR_GS); LAS float* RST = (LAS float*)(lds + LR_RST) + wave * 16; LAS float* LG = (LAS float*)(lds + LR_LG) + wave * 768;
    LAS int* tokE = (LAS int*)(lds + L_TOK); LAS float* tokW = (LAS float*)(lds + L_TOK + 1024); LAS unsigned* lcnt = (LAS unsigned*)(lds + L_LCNT); LAS unsigned* lbase = lcnt + 32;
    for (int blk = vcu; blk < NTOK / 128; blk += G) {
        const int b = (blk * 128) >> 14;
        __syncthreads();
        { const bf16* WRF = (const bf16*)(ws + WS_WRF) + (size_t)(layer * 2 + b) * 48 * 1024;
#pragma unroll
          for (int i = 0; i < 12; ++i) { const int n = wave * 6 + (i >> 1), hf = i & 1;
              __builtin_amdgcn_global_load_lds((const unsigned*)(WRF + (size_t)n * 1024 + hf * 512 + lane * 8), (LAS unsigned*)(lds + LR_WH + n * (LR_WSTR * 2) + hf * 1024), 16, 0, 0); } }
        if (tid < 256) { const int c = 4 * tid; const f32x4 gn = *(const f32x4*)(gain + c), sc = *(const f32x4*)(modl + b * 6144 + 4 * 1024 + c); *(LAS f32x4*)(GS + c) = gn * (sc + 1.0f); }
        else { const int c = 4 * (tid - 256); *(LAS f32x4*)(GS + 1024 + c) = *(const f32x4*)(modl + b * 6144 + 3 * 1024 + c); }
        if (tid < 32) lcnt[tid] = 0u;
        LDS_WAIT(); __builtin_amdgcn_s_barrier();
        const int mw = blk * 128 + wave * 16;
        {
            float gmv[2][8], shv[2][8];
#pragma unroll
            for (int j = 0; j < 2; ++j)
#pragma unroll
                for (int h = 0; h < 2; ++h) { const f32x4 gq = *(const LAS f32x4*)(GS + 512 * j + 8 * lane + 4 * h), sq = *(const LAS f32x4*)(GS + 1024 + 512 * j + 8 * lane + 4 * h);
#pragma unroll
                    for (int q = 0; q < 4; ++q) { gmv[j][4 * h + q] = gq[q]; shv[j][4 * h + q] = sq[q]; } }
            v4u rx[4][2], nx[4][2];
#pragma unroll
            for (int rr = 0; rr < 4; ++rr)
#pragma unroll
                for (int j = 0; j < 2; ++j) rx[rr][j] = *(const v4u*)(XB + (size_t)(mw + rr) * D + 512 * j + 8 * lane);
            for (int it = 0; it < 4; ++it) {
                const int m0 = mw + 4 * it;
                if (it + 1 < 4) {
#pragma unroll
                    for (int rr = 0; rr < 4; ++rr)
#pragma unroll
                        for (int j = 0; j < 2; ++j) nx[rr][j] = *(const v4u*)(XB + (size_t)(m0 + 4 + rr) * D + 512 * j + 8 * lane); }
#pragma unroll
                for (int rr = 0; rr < 4; ++rr) { float h[2][8]; float ss = 0.f;
#pragma unroll
                    for (int j = 0; j < 2; ++j) { unpack8(rx[rr][j], h[j]);
#pragma unroll
                        for (int q = 0; q < 8; ++q) ss += h[j][q] * h[j][q]; }
                    const float rstd = 1.0f / sqrtf(wave_sum(ss, lane) * (1.0f / D) + RMS_EPS);
                    if (lane == 0) RST[4 * it + rr] = rstd;
#pragma unroll
                    for (int j = 0; j < 2; ++j) {
#pragma unroll
                        for (int q = 0; q < 8; ++q) h[j][q] = sat_fp8((h[j][q] * rstd * gmv[j][q] + shv[j][q]) * FS_XN);
                        v2u w8; w8.x = pk4_fp8(h[j][0], h[j][1], h[j][2], h[j][3]); w8.y = pk4_fp8(h[j][4], h[j][5], h[j][6], h[j][7]);
                        *(v2u*)(XN + (size_t)(m0 + rr) * D + 512 * j + 8 * lane) = w8; } }
#pragma unroll
                for (int rr = 0; rr < 4; ++rr)
#pragma unroll
                    for (int j = 0; j < 2; ++j) rx[rr][j] = nx[rr][j];
            }
        }
        LDS_WAIT(); asm volatile("" ::: "memory");
        asm volatile("s_waitcnt vmcnt(0)" ::: "memory"); __builtin_amdgcn_s_barrier();
        {
            const int fr = lane & 15, fq = lane >> 4;
            const bf16* xrow = XB + (size_t)(mw + fr) * D + fq * 8;
            f32x4 acc[3];
#pragma unroll
            for (int t = 0; t < 3; ++t) acc[t] = (f32x4){0.f, 0.f, 0.f, 0.f};
            {
                constexpr int kg = 0; v4u xq8[32];
#pragma unroll
                for (int u = 0; u < 32; ++u) xq8[u] = *(const v4u*)(xrow + (kg + u) * 32);
#pragma unroll
                for (int u = 0; u < 32; ++u) { const int k0 = (kg + u) * 32 + fq * 8; const bf16x8 ax = __builtin_bit_cast(bf16x8, xq8[u]);
#pragma unroll
                    for (int t = 0; t < 3; ++t) { const bf16x8 bh = *(const LAS bf16x8*)(WH + (t * 16 + fr) * LR_WSTR + k0);
                        acc[t] = __builtin_amdgcn_mfma_f32_16x16x32_bf16(ax, bh, acc[t], 0, 0, 0); } }
            }
            const float* rb = (const float*)(ws + WS_RBIAS) + (layer * 2 + b) * 48;
#pragma unroll
            for (int t = 0; t < 3; ++t) { const float bias = rb[t * 16 + fr];
#pragma unroll
                for (int r = 0; r < 4; ++r) LG[(4 * fq + r) * 48 + t * 16 + fr] = acc[t][r] * RST[4 * fq + r] + bias; }
        }
        LDS_WAIT(); asm volatile("" ::: "memory");
        if (lane < 16) {
            const LAS float* lg = LG + lane * 48;
            float gl[4]; int gi = 0;
#pragma unroll
            for (int j = 0; j < 4; ++j) gl[j] = lg[j];
            float gmax = gl[0];
#pragma unroll
            for (int j = 1; j < 4; ++j) if (gl[j] > gmax) { gmax = gl[j]; gi = j; }
            float gsum = 0.f;
#pragma unroll
            for (int j = 0; j < 4; ++j) gsum += expf(gl[j] - gmax);
            const float gp = 1.0f / gsum;
            float e0v = -3.0e38f, e1v = -3.0e38f; int e0 = 0, e1 = 0;
#pragma unroll
            for (int j = 0; j < 8; ++j) { const float v = lg[4 + gi * 8 + j];
                if (v > e0v) { e1v = e0v; e1 = e0; e0v = v; e0 = j; } else if (v > e1v) { e1v = v; e1 = j; } }
            const float dd = expf(e1v - e0v), w0 = gp / (1.0f + dd), w1 = gp * dd / (1.0f + dd);
            const int rl = wave * 16 + lane;
            tokE[rl * 2] = gi * 8 + e0; tokE[rl * 2 + 1] = gi * 8 + e1; tokW[rl * 2] = w0; tokW[rl * 2 + 1] = w1;
        }
        {
            unsigned* cntg = (unsigned*)(ws + WS_CTL) + CW_CNT + layer * 32; unsigned* listi = (unsigned*)(ws + WS_LISTI); float* listw = (float*)(ws + WS_LISTW);
            __syncthreads();
            int e = 0; unsigned rank = 0;
            if (tid < 256) { e = tokE[tid]; rank = atomicAdd((unsigned*)&lcnt[e], 1u); }
            __syncthreads();
            if (tid < 32) { const unsigned n = lcnt[tid]; lbase[tid] = n ? atomicAdd(&cntg[tid], n) : 0u; }
            __syncthreads();
            if (tid < 256) { const unsigned pos = lbase[e] + rank; const unsigned m = (unsigned)(blk * 128 + (tid >> 1));
                listi[(size_t)e * NTOK + pos] = m * 2u + (unsigned)(tid & 1); listw[(size_t)e * NTOK + pos] = tokW[tid]; }
        }
    }
}

__device__ __forceinline__ void scan_phase(const KArgs a, LAS unsigned char* lds, int task0, int task1, int tstep, int lane, int wave) {
    unsigned char* ws = a.ws();
    asm volatile("" : "+v"(lane));
    const bf16* SB = (const bf16*)(ws + WS_SB); bf16* UG = (bf16*)(ws + WS_UG); const float* SC = (const float*)(ws + WS_SC);
    LAS float* ex = (LAS float*)lds;
    for (int task = task0; task < task1; task += tstep) {
        const int b = task & 1, g = task >> 1, p = lane;
        const float ar = SC[(g * 64 + p) * 2], ai = SC[(g * 64 + p) * 2 + 1];
        const bf16* sp = SB + ((size_t)g * NCH + b * 512 + wave * 64) * 128 + p; bf16* up = UG + ((size_t)g * NCH + b * 512 + wave * 64) * UPITCH + 512 + p;
        float er = 0.f, ei = 0.f;
#pragma unroll 1
        for (int jb = 0; jb < 64; jb += 32) { float sr[32], si[32];
#pragma unroll
            for (int j = 0; j < 32; ++j) { sr[j] = __builtin_bit_cast(float, (unsigned)sp[(size_t)(jb + j) * 128] << 16); si[j] = __builtin_bit_cast(float, (unsigned)sp[(size_t)(jb + j) * 128 + 64] << 16); }
#pragma unroll
            for (int j = 0; j < 32; ++j) { const float nr = ar * er - ai * ei + sr[j], ni = ar * ei + ai * er + si[j]; er = nr; ei = ni; } }
        ex[(wave * 2) * 64 + p] = er; ex[(wave * 2 + 1) * 64 + p] = ei;
        float a64r = ar, a64i = ai;
#pragma unroll
        for (int s = 0; s < 6; ++s) { const float nr = a64r * a64r - a64i * a64i, ni = 2.0f * a64r * a64i; a64r = nr; a64i = ni; }
        __syncthreads();
        float hr = 0.f, hi = 0.f;
        for (int w = 0; w < wave; ++w) { const float qr = ex[(w * 2) * 64 + p], qi = ex[(w * 2 + 1) * 64 + p]; const float nr = a64r * hr - a64i * hi + qr, ni = a64r * hi + a64i * hr + qi; hr = nr; hi = ni; }
#pragma unroll 1
        for (int jb = 0; jb < 64; jb += 32) { float sr[32], si[32];
#pragma unroll
            for (int j = 0; j < 32; ++j) { sr[j] = __builtin_bit_cast(float, (unsigned)sp[(size_t)(jb + j) * 128] << 16); si[j] = __builtin_bit_cast(float, (unsigned)sp[(size_t)(jb + j) * 128 + 64] << 16); }
#pragma unroll
            for (int j = 0; j < 32; ++j) { up[(size_t)(jb + j) * UPITCH] = (bf16)f2bf(hr); up[(size_t)(jb + j) * UPITCH + 64] = (bf16)f2bf(hi);
                const float nr = ar * hr - ai * hi + sr[j], ni = ar * hi + ai * hr + si[j]; hr = nr; hi = ni; } }
        __syncthreads();
    }
}

__device__ __forceinline__ void conv_phase(const KArgs a, int vcu, int G, int tid) {
    unsigned char* ws = a.ws();
    const bf16* BG = (const bf16*)(ws + WS_BG); const bf16* UU = (const bf16*)(ws + WS_UU); unsigned char* A3 = ws + WS_A3;
    asm volatile("" : "+v"(tid));
    const int cg = tid & 127, rq = tid >> 7; const float* cw = a.in(I_CW);
    float w0[8], w1[8], w2[8];
#pragma unroll
    for (int j = 0; j < 8; ++j) { w0[j] = cw[cg * 8 + j]; w1[j] = cw[1024 + cg * 8 + j]; w2[j] = cw[2048 + cg * 8 + j]; }
    for (int blk = vcu; blk < NTOK / 128; blk += G) {
        const int m0 = blk * 128 + rq * 32; const int t0 = m0 & (SEQ - 1);
        float u1[8], u2[8];
#pragma unroll
        for (int j = 0; j < 8; ++j) { u1[j] = 0.f; u2[j] = 0.f; }
        if (t0 >= 1) { const v4u q = *(const v4u*)(UU + (size_t)(m0 - 1) * D + cg * 8); u1[0] = bf_lo(q.x); u1[1] = bf_hi(q.x); u1[2] = bf_lo(q.y); u1[3] = bf_hi(q.y); u1[4] = bf_lo(q.z); u1[5] = bf_hi(q.z); u1[6] = bf_lo(q.w); u1[7] = bf_hi(q.w); }
        if (t0 >= 2) { const v4u q = *(const v4u*)(UU + (size_t)(m0 - 2) * D + cg * 8); u2[0] = bf_lo(q.x); u2[1] = bf_hi(q.x); u2[2] = bf_lo(q.y); u2[3] = bf_hi(q.y); u2[4] = bf_lo(q.z); u2[5] = bf_hi(q.z); u2[6] = bf_lo(q.w); u2[7] = bf_hi(q.w); }
        v4u qq[8], bqq[8], nq[8], nbq[8];
#pragma unroll
        for (int r = 0; r < 8; ++r) { const size_t off = (size_t)(m0 + r) * D + cg * 8; qq[r] = __builtin_nontemporal_load((const v4u*)(UU + off)); bqq[r] = __builtin_nontemporal_load((const v4u*)(BG + off)); }
        for (int r0 = 0; r0 < 32; r0 += 8) {
            if (r0 + 8 < 32) {
#pragma unroll
                for (int r = 0; r < 8; ++r) { const size_t off = (size_t)(m0 + r0 + 8 + r) * D + cg * 8; nq[r] = __builtin_nontemporal_load((const v4u*)(UU + off)); nbq[r] = __builtin_nontemporal_load((const v4u*)(BG + off)); } }
#pragma unroll
            for (int r = 0; r < 8; ++r) { const size_t off = (size_t)(m0 + r0 + r) * D + cg * 8; const v4u q = qq[r], bq = bqq[r];
                float u0[8], bb[8], z[8];
                u0[0] = bf_lo(q.x); u0[1] = bf_hi(q.x); u0[2] = bf_lo(q.y); u0[3] = bf_hi(q.y); u0[4] = bf_lo(q.z); u0[5] = bf_hi(q.z); u0[6] = bf_lo(q.w); u0[7] = bf_hi(q.w);
                bb[0] = bf_lo(bq.x); bb[1] = bf_hi(bq.x); bb[2] = bf_lo(bq.y); bb[3] = bf_hi(bq.y); bb[4] = bf_lo(bq.z); bb[5] = bf_hi(bq.z); bb[6] = bf_lo(bq.w); bb[7] = bf_hi(bq.w);
#pragma unroll
                for (int j = 0; j < 8; ++j) { z[j] = bb[j] * (w0[j] * u2[j] + w1[j] * u1[j] + w2[j] * u0[j]); u2[j] = u1[j]; u1[j] = u0[j]; }
                v2u o; o.x = pk4_fp8(sat_fp8(z[0] * FS_A3), sat_fp8(z[1] * FS_A3), sat_fp8(z[2] * FS_A3), sat_fp8(z[3] * FS_A3)); o.y = pk4_fp8(sat_fp8(z[4] * FS_A3), sat_fp8(z[5] * FS_A3), sat_fp8(z[6] * FS_A3), sat_fp8(z[7] * FS_A3)); *(v2u*)(A3 + off) = o; }
#pragma unroll
            for (int r = 0; r < 8; ++r) { qq[r] = nq[r]; bqq[r] = nbq[r]; }
        }
    }
}

template <int MODE>
__device__ __forceinline__ int moe_setup(const KArgs a, LAS unsigned char* lds, int G, int bx, int tid, int layer) {
    unsigned char* ws = a.ws();
    const unsigned* cntg = (const unsigned*)(ws + WS_CTL) + CW_CNT + layer * 32; const unsigned* listi = (const unsigned*)(ws + WS_LISTI); const unsigned* listw = (const unsigned*)(ws + WS_LISTW);
    asm volatile("" : "+v"(tid));
    LAS int* lc = (LAS int*)(lds + L_CNT); LAS int* tb = lc + 32; LAS int* nun = tb + 34;
    LAS gm::UnitRec* ut = (LAS gm::UnitRec*)(lds + L_UT); LAS unsigned* lists = (LAS unsigned*)(lds + L_LIST);
#if !MK_MULTI
    if (MODE == 1) return nun[0];
#endif
    if (tid < 64) {
        const int lane = tid, ex = lane & 31;
        const int c = (int)__hip_atomic_load(cntg + ex, __ATOMIC_RELAXED, __HIP_MEMORY_SCOPE_AGENT);
        const int tl = (c + 255) >> 8; int incl = tl;
#pragma unroll
        for (int o = 1; o < 32; o <<= 1) { const int t = shi(incl, lane - o, lane); if (ex >= o) incl += t; }
        const int excl = incl - tl, total = shi(incl, (lane & 32) + 31, lane);
        if (lane < 32) { lc[lane] = c; tb[lane] = excl; }
        const int U = total * 4; int start, end, stride, j;
        if ((G & 7) == 0) { const int x = bx & 7; start = 4 * ((x * total) / 8); end = 4 * (((x + 1) * total) / 8); stride = G >> 3; j = bx >> 3; } else { start = 0; end = U; stride = G; j = bx; }
        const int nxu = end - start, rounds = nxu / stride, rem = nxu - rounds * stride; const bool split = rem > 0 && 2 * rem <= stride;
        int uu = start + j + lane * stride, hm = 0; bool valid = lane < MAXU && lane < rounds;
        if (lane == rounds) { if (split) { uu = start + rounds * stride + (j >> 1); hm = 1 + (j & 1); valid = (j < 2 * rem) && lane < MAXU; } else valid = (j < rem) && lane < MAXU; }
        const int tg = uu >> 2, pn = uu & 3; int ee = 0;
#pragma unroll
        for (int k = 0; k < 31; ++k) ee += (shi(incl, (lane & 32) + k, lane) <= tg) ? 1 : 0;
        const int rt = tg - shi(excl, (lane & 32) + ee, lane);
        if (valid) { ut[lane].e = ee; ut[lane].rt = rt; ut[lane].tg = tg; ut[lane].pn = pn | (hm << 8); }
        const int n = __builtin_popcountll(__ballot(valid));
        if (lane == 0) { nun[0] = n; int L_, rk_; light_info(total, G, bx, L_, rk_); nun[1] = L_; nun[2] = rk_; }
    }
    __syncthreads();
    const int n = nun[0];
    for (int idx = tid; idx < n * 256; idx += 512) { const int ui = idx >> 8, r = idx & 255; const int e = ut[ui].e, pos = ut[ui].rt * 256 + r; const bool ok = pos < lc[e];
        lists[ui * 512 + r] = ok ? listi[(size_t)e * NTOK + pos] : 0xffffffffu; lists[ui * 512 + 256 + r] = ok ? listw[(size_t)e * NTOK + pos] : 0u; }
    __syncthreads();
    return n;
}

template <int LO, int HI>
__global__ void __launch_bounds__(NWAVES * 64, 2) fwd_kernel(Args args) {
    extern __shared__ __attribute__((aligned(16))) unsigned char lds_raw[];
    LAS unsigned char* lds = (LAS unsigned char*)lds_raw;
    const int wave = __builtin_amdgcn_readfirstlane((int)threadIdx.x >> 6); const int tid0_ = threadIdx.x;
    const int G = gridDim.x; int bx = blockIdx.x; int vcu = (G % 8 == 0) ? (bx % 8) * (G / 8) + bx / 8 : bx; int lok = 0;
    volatile LAS unsigned* MISC = (volatile LAS unsigned*)(lds + L_MISC);
    if (tid0_ < 32) MISC[tid0_] = 0u;
    __syncthreads();
    XcdBarrier bar; bar.bar = nullptr; bar.x = 0; bar.st = nullptr;
    if constexpr (HI - LO > 1) bar = xcd_barrier_post((unsigned*)(args.ws + WS_CTL) + CW_BAR, MISC + 8, wave);
#define GRID_BAR() do { XcdBarrier b_ = bar; asm volatile("" : "+s"(b_.bar), "+s"(b_.x)); xcd_barrier<false>(b_, wave); } while (0)
#define XCD_BAR() do { XcdBarrier b_ = bar; asm volatile("" : "+s"(b_.bar), "+s"(b_.x)); xcd_barrier<true>(b_, wave); } while (0)
    constexpr int lo = LO, hi = HI;
#ifndef PHM
#define PHM 0x3ffff
#endif
#define EN(s) (((PHM) >> (s)) & 1)
#ifndef DBLM
#define DBLM 0
#endif
#define REP(s) for (int rep_ = 0; rep_ < 1 + (((DBLM) >> (s)) & 1); ++rep_)
#define IN(k) (lo <= (k) && (k) < hi)
#define SEAM(k) do { if (IN(k) && IN((k) + 1)) GRID_BAR(); } while (0)
#define SEAM_L(k) do { if (IN(k) && IN((k) + 1)) XCD_BAR(); } while (0)
#define PHASE_ARGS const int lane = fresh_lane(), tid = wave * 64 + lane; (void)tid; const KArgs a = fresh_args(); unsigned char* const ws = a.ws(); const float* const mod = (const float*)(ws + WS_MOD); (void)mod

    if (EN(0) && IN(0)) REP(0) { PHASE_ARGS; p0_prologue(a, lds, vcu, G, tid, lane, wave); } SEAM(0);
    if constexpr (HI - LO > 1) if (IN(0) && IN(1)) { lok = __builtin_amdgcn_readfirstlane((int)MISC[8 + 2]);
        if (lok) { const int rk_ = __builtin_amdgcn_readfirstlane((int)MISC[8 + 3]), x_ = (int)bar.x; vcu = x_ * 32 + rk_; bx = rk_ * 8 + x_; } }

    if (EN(1) && IN(1)) REP(1) { PHASE_ARGS; if (wave == 0) for (int row_ = vcu; row_ < 192; row_ += G) router_fold_row(a, row_, lane);
        norm_phase<false, false, true>(a, lds, vcu, G, tid, lane, wave, a.in(I_X), nullptr, nullptr, a.in(I_N1G), mod, 0, nullptr); } SEAM_L(1);
    if (EN(2) && IN(2)) REP(2) { PHASE_ARGS; gm::RegSched<0> S; S.init(ws + WS_XN, ws + WS_WIN, 1024, 1024, G, bx); gm::EpiInproj E{(bf16*)(ws + WS_UG)};
        gm::gemm_phase<gm::EpiInproj, gm::RegSched<0>, true>(lds, S, E, wave); } SEAM(2);
    if (EN(3) && IN(3)) REP(3) { PHASE_ARGS; gm::SsmSched<0> S; S.init(ws + WS_UG, ws + WS_BM, G, vcu); gm::EpiS1 E{(bf16*)(ws + WS_SB)};
        gm::gemm_phase<gm::EpiS1, gm::SsmSched<0>, true>(lds, S, E, wave); } SEAM_L(3);
    if (EN(4) && IN(4)) REP(4) { PHASE_ARGS;
        if (lok) { const int x_ = vcu >> 5, rk_ = vcu & 31;
            if (rk_ < 16) scan_phase(a, lds, 16 * x_ + rk_, 16 * x_ + rk_ + 1, 1, lane, wave);
            else deferred_items(a, lds, 0, DEF_A, (x_ * 16 + rk_ - 16) * NWAVES + wave, 128 * NWAVES, wave); }
        else { scan_phase(a, lds, vcu, 2 * NGRP, G, lane, wave);
            if (G == 256 && vcu >= 128) deferred_items(a, lds, 0, DEF_A, (vcu - 128) * NWAVES + wave, 128 * NWAVES, wave); } } SEAM_L(4);
    if (EN(5) && IN(5)) REP(5) { PHASE_ARGS; gm::SsmSched<1> S; S.init(ws + WS_UG, ws + WS_BT, G, vcu); S.B2s = (const char*)(ws + WS_CM); if (lok) { S.G = 32; S.vcu = (vcu >> 5) * 64 + (vcu & 31); S.lim = 2; } gm::EpiY E{(bf16*)(ws + WS_GG)};
        gm::gemm_phase<gm::EpiY, gm::SsmSched<1>, true>(lds, S, E, wave); } SEAM(5);
    if (EN(6) && IN(6)) REP(6) { PHASE_ARGS; gm::RegSched<1> S; S.init(ws + WS_GG, ws + WS_WGLU, 2048, 1024, G, bx); gm::EpiGlu E{a.in(I_X), (bf16*)(ws + WS_XB), mod + 2 * 1024};
        gm::gemm_phase<gm::EpiGlu, gm::RegSched<1>, true>(lds, S, E, wave); } SEAM_L(6);

    for (int l = 0; l < 2; ++l) {
        const int pb = 7 + 7 * l;
        int z0_ = 0; asm volatile("" : "+s"(z0_)); LAS unsigned char* const lds_l = lds + z0_;
        if (l == 1) {
            if (EN(10) && IN(10)) REP(10) { PHASE_ARGS;
                {
                    LAS int* nun_ = (LAS int*)(lds_l + L_CNT) + 66;
                    if (tid == 0) { const unsigned* cntg = (const unsigned*)(ws + WS_CTL) + CW_CNT; int tot = 0; for (int e_ = 0; e_ < 32; ++e_) tot += (int)((__hip_atomic_load(cntg + e_, __ATOMIC_RELAXED, __HIP_MEMORY_SCOPE_AGENT) + 255u) >> 8);
                        int L_, rk_; light_info(tot, G, bx, L_, rk_); nun_[1] = L_; }
                    __syncthreads();
                    const int done_ = ((G == 256) ? DEF_A : 0) + nun_[1] * (DEF_QB + DEF_QC);
                    deferred_items(a, lds_l, done_, MOE_WITEMS - done_, vcu * NWAVES + wave, G * NWAVES, wave);
                    __syncthreads();
                }
                norm_phase<true, false, false>(a, lds_l, vcu, G, tid, lane, wave, ws + WS_XB, (bf16*)(ws + WS_XB), nullptr, a.in(I_N1G) + 1024, mod + 2 * 6144, 0, mod); } SEAM_L(10);
            if (EN(11) && IN(11)) REP(11) {
                { PHASE_ARGS; gm::RegSched<0> S; S.init(ws + WS_XN, ws + WS_WCIN, 2048, 1024, G, bx); gm::EpiCV E{(bf16*)(ws + WS_UU)};
                  gm::gemm_phase<gm::EpiCV, gm::RegSched<0>, true>(lds_l, S, E, wave); }
                { PHASE_ARGS; gm::RegSched<0> S; S.init(ws + WS_XN, ws + WS_WCIN + (size_t)2048 * 1024 * 2, 1024, 1024, G, bx); gm::EpiBf16 E{(bf16*)(ws + WS_BG), 1024};
                  gm::gemm_phase<gm::EpiBf16, gm::RegSched<0>, true>(lds_l, S, E, wave); }
            } SEAM(11);
            if (EN(12) && IN(12)) REP(12) { PHASE_ARGS; conv_phase(a, vcu, G, tid); } SEAM_L(12);
            if (EN(13) && IN(13)) REP(13) { PHASE_ARGS; gm::RegSched<0, true> S; S.init(ws + WS_A3, ws + WS_WCOUT, 1024, 1024, G, bx); gm::EpiResid E{(bf16*)(ws + WS_XB), mod + 2 * 6144 + 2 * 1024};
                gm::gemm_phase<gm::EpiResid, gm::RegSched<0, true>, true>(lds_l, S, E, wave); } SEAM_L(13);
        }
        if (EN(7) && IN(pb)) REP(7) { PHASE_ARGS; router_phase(a, lds_l, vcu, G, tid, lane, wave, a.in(I_N2G) + l * 1024, mod + l * 2 * 6144, l); } SEAM(pb);
        if (EN(8) && IN(pb + 1)) REP(8) { PHASE_ARGS; const int n = moe_setup<0>(a, lds_l, G, bx, tid, l);
            gm::MoeSched<0> S; S.init(ws + WS_XN, ws + WS_W13 + (size_t)l * 32 * 4 * 256 * 2048, (const LAS gm::UnitRec*)(lds_l + L_UT), (const LAS unsigned*)(lds_l + L_LIST), n);
            gm::EpiMoe1 E{ws + WS_HB};
            gm::gemm_phase<gm::EpiMoe1, gm::MoeSched<0>, true>(lds_l, S, E, wave);
            if (l == 0) { LAS int* nun_ = (LAS int*)(lds_l + L_CNT) + 66; const int rk_ = nun_[2]; const int doneA = (G == 256) ? DEF_A : 0;
                if (rk_ >= 0) deferred_items(a, lds_l, doneA + rk_ * DEF_QB, DEF_QB, wave, NWAVES, wave); } } SEAM_L(pb + 1);
        if (EN(9) && IN(pb + 2)) REP(9) { PHASE_ARGS; const int n = moe_setup<1>(a, lds_l, G, bx, tid, l);
            gm::MoeSched<1> S; S.init(ws + WS_HB, ws + WS_W2 + (size_t)l * 32 * 1024 * 1024, (const LAS gm::UnitRec*)(lds_l + L_UT), (const LAS unsigned*)(lds_l + L_LIST), n);
            gm::EpiMoe2 E{ws + WS_O2, (const LAS unsigned*)(lds_l + L_LIST)};
            gm::gemm_phase<gm::EpiMoe2, gm::MoeSched<1>, true>(lds_l, S, E, wave);
            if (l == 0) { LAS int* nun_ = (LAS int*)(lds_l + L_CNT) + 66; const int L_ = nun_[1], rk_ = nun_[2]; const int doneA = (G == 256) ? DEF_A : 0;
                if (rk_ >= 0) deferred_items(a, lds_l, doneA + L_ * DEF_QB + rk_ * DEF_QC, DEF_QC, wave, NWAVES, wave); } } SEAM(pb + 2);
    }
    if (EN(17) && IN(17)) REP(17) { PHASE_ARGS; norm_phase<true, true, false>(a, lds, vcu, G, tid, lane, wave, ws + WS_XB, nullptr, a.out(), a.in(I_FG), nullptr, 0, mod + 2 * 6144); }
#undef IN
#undef SEAM
}

extern "C" void kernel_launch(void* const* d_in, const int* in_sizes, int n_in, void* d_out, int out_size, void* d_ws, size_t ws_size, hipStream_t stream) {
    static int grid = 0;
    if (grid == 0) {
        if (n_in != 27 || in_sizes[0] != NTOK * D || out_size != NTOK * D || ws_size < WS_END) {
            fprintf(stderr, "kernel_launch: unexpected shapes (n_in %d, in0 %d, out %d, ws %zu < %zu); nothing launched\n", n_in, n_in > 0 ? in_sizes[0] : -1, out_size, ws_size, (size_t)WS_END); grid = -1; return; }
        int dev = 0, cus = 0, per_cu = 0;
        if (hipGetDevice(&dev) != hipSuccess || hipDeviceGetAttribute(&cus, hipDeviceAttributeMultiprocessorCount, dev) != hipSuccess) { grid = -1; return; }
#if MK_MULTI
#define SET_ATTR(p) ok = ok && (hipFuncSetAttribute((const void*)fwd_kernel<p, p + 1>, hipFuncAttributeMaxDynamicSharedMemorySize, LDS_BYTES) == hipSuccess)
        bool ok = true; SET_ATTR(0); SET_ATTR(1); SET_ATTR(2); SET_ATTR(3); SET_ATTR(4); SET_ATTR(5); SET_ATTR(6); SET_ATTR(7); SET_ATTR(8); SET_ATTR(9);
        SET_ATTR(10); SET_ATTR(11); SET_ATTR(12); SET_ATTR(13); SET_ATTR(14); SET_ATTR(15); SET_ATTR(16); SET_ATTR(17);
        if (!ok) { fprintf(stderr, "kernel_launch: hipFuncSetAttribute failed\n"); grid = -1; return; }
        per_cu = 1;
#else
        if (hipFuncSetAttribute((const void*)fwd_kernel<0, NPH>, hipFuncAttributeMaxDynamicSharedMemorySize, LDS_BYTES) != hipSuccess) { fprintf(stderr, "kernel_launch: hipFuncSetAttribute failed\n"); grid = -1; return; }
        if (hipOccupancyMaxActiveBlocksPerMultiprocessor(&per_cu, (const void*)fwd_kernel<0, NPH>, NWAVES * 64, LDS_BYTES) != hipSuccess || per_cu < 1)
            fprintf(stderr, "kernel_launch: note: occupancy query reports %d workgroups per CU\n", per_cu);
#endif
        (void)hipGetLastError();
        grid = cus;
    }
    if (grid < 0) return;
    if (hipMemsetAsync((char*)d_ws + WS_CTL, 0, CTL_ZERO_BYTES, stream) != hipSuccess) return;
    Args a{};
    for (int i = 0; i < 27; ++i) a.in[i] = (const float*)d_in[i];
    a.out = (float*)d_out; a.ws = (unsigned char*)d_ws;
#if MK_MULTI
#define LAUNCH_PH(p) do { a.ph_lo = p; a.ph_hi = p + 1; hipLaunchKernelGGL((fwd_kernel<p, p + 1>), dim3(grid), dim3(NWAVES * 64), LDS_BYTES, stream, a); } while (0)
    LAUNCH_PH(0); LAUNCH_PH(1); LAUNCH_PH(2); LAUNCH_PH(3); LAUNCH_PH(4); LAUNCH_PH(5); LAUNCH_PH(6); LAUNCH_PH(7); LAUNCH_PH(8); LAUNCH_PH(9);
    LAUNCH_PH(10); LAUNCH_PH(11); LAUNCH_PH(12); LAUNCH_PH(13); LAUNCH_PH(14); LAUNCH_PH(15); LAUNCH_PH(16); LAUNCH_PH(17);
#else
    a.ph_lo = 0; a.ph_hi = NPH;
    hipLaunchKernelGGL((fwd_kernel<0, NPH>), dim3(grid), dim3(NWAVES * 64), LDS_BYTES, stream, a);
#endif
}
```

```cpp
#include <hip/hip_runtime.h>
#include <cstdio>
#include <cstdint>
#include <type_traits>

#ifndef MK_MULTI
#define MK_MULTI 0
#endif

#define GAS __attribute__((address_space(1)))
#define LAS __attribute__((address_space(3)))
typedef unsigned short bf16;
typedef unsigned v4u __attribute__((ext_vector_type(4)));
typedef unsigned v2u __attribute__((ext_vector_type(2)));
typedef float f32x4 __attribute__((ext_vector_type(4)));
typedef float f32x2 __attribute__((ext_vector_type(2)));
typedef short bf16x8 __attribute__((ext_vector_type(8)));

constexpr int NTOK = 32768, D = 1024, SEQ = 16384;
constexpr int NGRP = 64, NST = 64, GCH = 16, LC = 32;
constexpr int NCH = NTOK / LC;
constexpr int UPITCH = 640;
constexpr int NEXP = 32, DEXP = 512;
constexpr float RMS_EPS = 1e-6f;
constexpr int NWAVES = 8;

constexpr size_t MiB = 1u << 20;
constexpr size_t WS_CTL = 0, CTL_ZERO_BYTES = 128 * 1024;
constexpr size_t WS_RBIAS = 192 * 1024;
constexpr size_t WS_WRF = 256 * 1024;
constexpr size_t WS_MOD = 1 * MiB;
constexpr size_t WS_SC = 1 * MiB + 512 * 1024;
constexpr size_t WS_WR = 1 * MiB + 640 * 1024;
constexpr size_t WS_WIN = 2 * MiB, WS_WGLU = 4 * MiB, WS_WCIN = 8 * MiB, WS_WCOUT = 14 * MiB;
constexpr size_t WS_BM = 16 * MiB;
constexpr size_t WS_LISTI = 16 * MiB, WS_LISTW = 20 * MiB;
constexpr size_t WS_BT = 24 * MiB;
constexpr size_t WS_CM = 26 * MiB;
constexpr size_t WS_W13 = 64 * MiB;
constexpr size_t WS_W2 = 192 * MiB;
constexpr size_t WS_XN = 256 * MiB;
constexpr size_t WS_SCR = 320 * MiB;
constexpr size_t WS_XB = WS_SCR;
constexpr size_t WS_UG = WS_SCR, WS_SB = WS_SCR + 80 * MiB, WS_GG = WS_SCR + 112 * MiB;
constexpr size_t WS_BG = WS_SCR + 64 * MiB, WS_UU = WS_W13, WS_A3 = WS_SCR + 192 * MiB;
constexpr size_t WS_HB = WS_SCR + 64 * MiB, WS_O2 = WS_SCR + 136 * MiB;
constexpr size_t WS_END = 584 * MiB;
constexpr int CW_BAR = 4096;
constexpr int CW_CNT = 16384;

#if !MK_MULTI
__device__ unsigned g_ctl[CW_CNT + 128];
#define CTLP(ws_) (g_ctl)
#else
#define CTLP(ws_) ((unsigned*)((ws_) + WS_CTL))
#endif
constexpr int L_STAGE = 0;
constexpr int L_LIST = 133120;
constexpr int L_UT = 145408;
constexpr int L_CNT = 145664;
constexpr int L_RED = 149504;
constexpr int L_TOK = 151808;
constexpr int L_LCNT = 153856;
constexpr int L_MISC = 155520;
constexpr int LDS_BYTES = 155648;
constexpr int MAXU = 6;

#define LDS_WAIT() asm volatile("s_waitcnt lgkmcnt(0)" ::: "memory")
#define VM_WAIT() asm volatile("s_waitcnt vmcnt(0)" ::: "memory")
__device__ __forceinline__ unsigned f2bf(float f) { unsigned u = __builtin_bit_cast(unsigned, f); return (u + 0x7fffu + ((u >> 16) & 1u)) >> 16; }
typedef __bf16 bf16x2_t __attribute__((ext_vector_type(2)));
__device__ __forceinline__ unsigned pk2(float lo, float hi) { const f32x2 v = {lo, hi}; return __builtin_bit_cast(unsigned, __builtin_convertvector(v, bf16x2_t)); }
__device__ __forceinline__ float bf_lo(unsigned w) { return __builtin_bit_cast(float, w << 16); }
__device__ __forceinline__ float bf_hi(unsigned w) { return __builtin_bit_cast(float, w & 0xffff0000u); }
constexpr float FS_XN = 16.f, FS_W13 = 64.f, FS_H = 8.f, FS_W2 = 64.f, FS_O = 16.f, FS_A3 = 8.f, FS_WCO = 64.f;
__device__ __forceinline__ unsigned pk4_fp8(float a, float b, float c, float d) { int p = __builtin_amdgcn_cvt_pk_fp8_f32(a, b, 0, false); p = __builtin_amdgcn_cvt_pk_fp8_f32(c, d, p, true); return (unsigned)p; }
__device__ __forceinline__ void unpack8_fp8(v2u q, float (&f)[8]) {
    typedef float f32x2_ __attribute__((ext_vector_type(2)));
    const f32x2_ a = __builtin_amdgcn_cvt_pk_f32_fp8((int)q.x, false), b = __builtin_amdgcn_cvt_pk_f32_fp8((int)q.x, true), c = __builtin_amdgcn_cvt_pk_f32_fp8((int)q.y, false), d = __builtin_amdgcn_cvt_pk_f32_fp8((int)q.y, true);
    f[0] = a[0]; f[1] = a[1]; f[2] = b[0]; f[3] = b[1]; f[4] = c[0]; f[5] = c[1]; f[6] = d[0]; f[7] = d[1]; }
__device__ __forceinline__ float sat_fp8(float x) { return __builtin_amdgcn_fmed3f(x, -448.f, 448.f); }
__device__ __forceinline__ unsigned cvt_pk_bf16(float lo, float hi) { unsigned r; asm volatile("v_cvt_pk_bf16_f32 %0, %1, %2" : "=v"(r) : "v"(lo), "v"(hi)); return r; }
__device__ __forceinline__ float shx(float v, int mask, int lane) { return __builtin_bit_cast(float, __builtin_amdgcn_ds_bpermute((lane ^ mask) << 2, __builtin_bit_cast(int, v))); }
__device__ __forceinline__ int shi(int v, int src, int lane) { (void)lane; return __builtin_amdgcn_ds_bpermute(src << 2, v); }
__device__ __forceinline__ float dpp_add(float v, int ctrl_sel) {
    const int vi = __builtin_bit_cast(int, v); int r;
    if (ctrl_sel == 0) r = __builtin_amdgcn_update_dpp(0, vi, 0xB1, 0xf, 0xf, true);
    else if (ctrl_sel == 1) r = __builtin_amdgcn_update_dpp(0, vi, 0x4E, 0xf, 0xf, true);
    else if (ctrl_sel == 2) r = __builtin_amdgcn_update_dpp(0, vi, 0x141, 0xf, 0xf, true);
    else r = __builtin_amdgcn_update_dpp(0, vi, 0x140, 0xf, 0xf, true);
    return v + __builtin_bit_cast(float, r);
}
__device__ __forceinline__ float wave_sum(float v, int lane) {
    v = dpp_add(v, 0); v = dpp_add(v, 1); v = dpp_add(v, 2); v = dpp_add(v, 3);
    v += shx(v, 16, lane); v += shx(v, 32, lane);
    return v;
}
__device__ __forceinline__ float sigmoidf_(float x) { return __builtin_amdgcn_rcpf(1.0f + __builtin_amdgcn_exp2f(-1.4426950408889634f * x)); }
__device__ __forceinline__ float gelu_tanh(float x) { const float x2 = x * x, u = x * (-2.3022082f - 0.10294324f * x2); return x * __builtin_amdgcn_rcpf(1.0f + __builtin_amdgcn_exp2f(u)); }

__device__ __forceinline__ int fresh_lane() { unsigned m_ = ~0u; asm volatile("" : "+s"(m_)); return (int)__builtin_amdgcn_mbcnt_hi(m_, __builtin_amdgcn_mbcnt_lo(m_, 0u)); }
#define XB_TMO      128
#define XB_XCNT(j)  (256  + 64 * (j))
#define XB_XSUB(j)  (1280 + 64 * (j))
#define XB_XGEN(j)  (2304 + 64 * (j))
#define XB_TOP      3328
#define XB_TOPGEN   3392
#define XCD_BAR_WORDS 3456
#define XB_SPIN_CAP (1u << 18)
__device__ __forceinline__ unsigned xb_ld(unsigned* p)              { return __hip_atomic_load(p, __ATOMIC_RELAXED, __HIP_MEMORY_SCOPE_AGENT); }
__device__ __forceinline__ unsigned xb_add(unsigned* p, unsigned v) { return __hip_atomic_fetch_add(p, v, __ATOMIC_RELAXED, __HIP_MEMORY_SCOPE_AGENT); }
__device__ __forceinline__ unsigned xb_xcc_id() { return (unsigned)__builtin_amdgcn_s_getreg((3 << 11) | 20) & 0xFu; }
#define XB_SPIN(cond, bar) do { unsigned _sp = 0; while (cond) { __builtin_amdgcn_s_sleep(1); \
    if ((++_sp & 255u) == 0u) { if (xb_ld(&(bar)[XB_TMO])) break; if (_sp > XB_SPIN_CAP) { atomicAdd(&(bar)[XB_TMO], 1u); break; } } } } while (0)
struct XcdBarrier { unsigned* bar; unsigned x; volatile LAS unsigned* st; };
__device__ __forceinline__ XcdBarrier xcd_barrier_post(unsigned* bar, volatile LAS unsigned* st, int wave) {
    XcdBarrier b; b.bar = bar; b.x = xb_xcc_id(); b.st = st;
    if (wave == 0 && fresh_lane() == 0) st[3] = xb_add(&bar[XB_XCNT(b.x)], 1u);
    return b;
}
__device__ __forceinline__ void xcd_barrier_complete(unsigned* bar, unsigned x, unsigned& nloc, unsigned& nx, unsigned& full) {
    const unsigned G = gridDim.x * gridDim.y * gridDim.z;
    unsigned sum, cnt, mine, sp = 0u;
    for (;;) {
        sum = 0u; cnt = 0u; mine = 0u; full = 0u;
#pragma unroll
        for (unsigned j = 0; j < 16; ++j) { const unsigned c = xb_ld(&bar[XB_XCNT(j)]); sum += c; cnt += (c > 0u) ? 1u : 0u; mine = (j == x) ? c : mine; full += (j < 8u && c == 32u) ? 1u : 0u; }
        if (sum == G) break;
        __builtin_amdgcn_s_sleep(1);
        if ((++sp & 255u) == 0u) { if (xb_ld(&bar[XB_TMO])) break; if (sp > XB_SPIN_CAP) { atomicAdd(&bar[XB_TMO], 1u); break; } }
    }
    nloc = mine > 0u ? mine : 1u; nx = cnt > 0u ? cnt : 1u;
}
template <bool LOCAL = false>
__device__ __forceinline__ void xcd_barrier(const XcdBarrier& b, int wave) {
    asm volatile("s_waitcnt vmcnt(0)" ::: "memory");
    __syncthreads();
    if (wave == 0 && fresh_lane() == 0) {
        unsigned* bar = b.bar;
        __builtin_amdgcn_s_waitcnt(0);
        unsigned nloc = b.st[0], nx = b.st[1];
        if (nloc == 0u) { unsigned full; xcd_barrier_complete(bar, b.x, nloc, nx, full); b.st[0] = nloc; b.st[1] = nx; b.st[2] = (full == 8u && nx == 8u && gridDim.x == 256u) ? 1u : 0u; }
        const unsigned old = xb_add(&bar[XB_XSUB(b.x)], 1u);
        const unsigned gen = old / nloc;
        if (old + 1u == (gen + 1u) * nloc) {
            if (!(LOCAL && b.st[2] != 0u)) {
                __builtin_amdgcn_fence(__ATOMIC_RELEASE, "agent");
                asm volatile("s_waitcnt vmcnt(0)" ::: "memory");
                const unsigned og = xb_add(&bar[XB_TOP], 1u);
                const unsigned tg = og / nx;
                if (og + 1u == (tg + 1u) * nx) xb_add(&bar[XB_TOPGEN], 1u);
                else XB_SPIN(xb_ld(&bar[XB_TOPGEN]) == tg, bar);
            }
            __builtin_amdgcn_fence(__ATOMIC_ACQUIRE, "agent");
            xb_add(&bar[XB_XGEN(b.x)], 1u);
            asm volatile("s_waitcnt vmcnt(0)" ::: "memory");
        } else {
            XB_SPIN(xb_ld(&bar[XB_XGEN(b.x)]) == gen, bar);
            __builtin_amdgcn_fence(__ATOMIC_ACQUIRE, "agent");
            asm volatile("s_waitcnt vmcnt(0)" ::: "memory");
        }
    }
    __syncthreads();
}

struct Args { const float* in[27]; float* out; unsigned char* ws; int ph_lo, ph_hi; };
#define CAS __attribute__((address_space(4)))
struct KArgs {
    const CAS char* kp;
    __device__ __forceinline__ const float* in(int k) const { return *(const float* const CAS*)(kp + 8 * k); }
    __device__ __forceinline__ float* out() const { return *(float* const CAS*)(kp + 8 * 27); }
    __device__ __forceinline__ unsigned char* ws() const { return *(unsigned char* const CAS*)(kp + 8 * 28); }
};
__device__ __forceinline__ KArgs fresh_args() { KArgs k; k.kp = (const CAS char*)__builtin_amdgcn_kernarg_segment_ptr(); asm volatile("" : "+s"(k.kp)); return k; }

namespace gm {
constexpr int BM = 256, BK = 64, HALF = 128, HTB = HALF * BK * 2, STAGE_BYTES = 8 * HTB, NXCD = 8, WGM = 8;
__host__ __device__ __forceinline__ int lds_byte(int r, int c) { const int st = (r >> 4) * 2 + (c >> 5), rr = r & 15, cc = c & 31, ob = rr * 64 + cc * 2; return st * 1024 + (ob ^ (((ob >> 9) & 1) << 5)); }
__host__ __device__ __forceinline__ void stage_rc(int b, int& R, int& C) { const int st = b / 1024, sb = b % 1024, swz = sb ^ (((sb >> 9) & 1) << 5); R = (st >> 1) * 16 + swz / 64; C = (st & 1) * 32 + (swz % 64) / 2; }
__host__ __device__ __forceinline__ int perm32(int rho) { const int n = rho >> 4, i = rho & 15; return 8 * (i >> 2) + 4 * n + (i & 3); }

struct Unit { const char* A; const char* B; const char* B2; int p0, p1, p2, p3; int nt, kjump; int hm; };

typedef int v8i __attribute__((ext_vector_type(8)));
typedef int v4i_ __attribute__((ext_vector_type(4)));
__device__ __forceinline__ v8i cat8(bf16x8 lo, bf16x8 hi) { const v4i_ a = __builtin_bit_cast(v4i_, lo), b = __builtin_bit_cast(v4i_, hi); return __builtin_shufflevector(a, b, 0, 1, 2, 3, 4, 5, 6, 7); }
template <class Epi, class Sched, bool ALIGN_EPI>
__device__ __forceinline__ void gemm_phase(LAS unsigned char* lds, const Sched& S, const Epi& E, int wave_) {
    int tid_ = wave_ * 64 + fresh_lane(); asm volatile("" : "+v"(tid_));
    const int tid = tid_, wid = __builtin_amdgcn_readfirstlane(tid >> 6), lane = tid & 63, wr = wid >> 2, wc = wid & 3, fr = lane & 15, fq = lane >> 4;
    int nt = S.nt; int kjump = 0;
    const long kstepA = S.kstepA, kstepB = S.kstepB, hstepA = S.hstepA, hstepB = Epi::PERM2 ? S.hstepB / 16 : S.hstepB;
    unsigned voffA[2], voffB[2], voffB2[2] = {0u, 0u}; long hstepB2 = 0; if constexpr (Sched::BSPLIT) hstepB2 = S.hstepB2;
#pragma unroll
    for (int i = 0; i < 2; ++i) { int R, C; stage_rc(tid * 16 + i * 8192, R, C); const int Rb = Epi::PERM2 ? (64 * (R >> 5) + 16 * ((R >> 2) & 3) + 4 * ((R >> 4) & 1) + (R & 3)) : Epi::PERM ? ((R & ~31) + perm32(R & 31)) : R;
        voffA[i] = S.voffA(R, C); voffB[i] = S.voffB(Rb, C); if constexpr (Sched::BSPLIT) voffB2[i] = S.voffB2(Rb, C); }
    unsigned goff[2][2] = {{0u, 0u}, {0u, 0u}};
    const unsigned ldsw = (unsigned)wid * 1024u;
    const int aoff = lds_byte(wr * 64 + fr, fq * 8), boff = lds_byte(wc * 32 + fr, fq * 8);
#define G_SA(b, h) (((b) * 2 + (h)) * HTB)
#define G_SB(b, h) ((4 + (b) * 2 + (h)) * HTB)
#define G_STAGE(bufoff, gbase, voff) do { _Pragma("unroll") for (int _i = 0; _i < 2; ++_i) \
        __builtin_amdgcn_global_load_lds((const unsigned*)((const char*)(gbase) + (voff)[_i]), (LAS unsigned*)(lds + (bufoff) + ldsw + _i * 8192), 16, 0, 0); } while (0)
#define G_STAGE_A(b, h, p) do { if constexpr (Sched::GATHER) { G_STAGE(G_SA(b, h), (p), goff[h]); } else { G_STAGE(G_SA(b, h), (p) + ((h) ? hstepA : 0), voffA); } } while (0)
#define G_STAGE_B(b, h, p) G_STAGE(G_SB(b, h), (p) + ((h) ? hstepB : 0), voffB)
#define G_STAGE_B2(b, h, p, c2) do { if constexpr (Sched::BSPLIT) { unsigned vs_[2]; vs_[0] = (c2) ? voffB2[0] : voffB[0]; vs_[1] = (c2) ? voffB2[1] : voffB[1]; G_STAGE(G_SB(b, h), (p) + ((h) ? ((c2) ? hstepB2 : hstepB) : 0), vs_); } else G_STAGE_B(b, h, p); } while (0)
#define G_LDA(dst, b, h) do { _Pragma("unroll") for (int m = 0; m < 4; ++m) _Pragma("unroll") for (int k = 0; k < 2; ++k) dst[m][k] = *(const LAS bf16x8*)(lds + G_SA(b, h) + aoff + m * 2048 + k * 1024); } while (0)
#define G_LDB(dst, b, h) do { _Pragma("unroll") for (int n = 0; n < 2; ++n) _Pragma("unroll") for (int k = 0; k < 2; ++k) dst[n][k] = *(const LAS bf16x8*)(lds + G_SB(b, h) + boff + n * 2048 + k * 1024); } while (0)
#define G_MMA(ai, bj, At, Bt) do { __builtin_amdgcn_s_setprio(1); _Pragma("unroll") for (int m = 0; m < 4; ++m) _Pragma("unroll") for (int n = 0; n < 2; ++n) { \
        if constexpr (Sched::FP8) { const v8i a8_ = cat8(Bt[n][0], Bt[n][1]), b8_ = cat8(At[m][0], At[m][1]); \
            asm volatile("v_mfma_f32_16x16x128_f8f6f4 %0, %1, %2, %0" : "+v"(acc[ai][bj][m][n]) : "v"(a8_), "v"(b8_)); }     \
        else { _Pragma("unroll") for (int k = 0; k < 2; ++k) acc[ai][bj][m][n] = __builtin_amdgcn_mfma_f32_16x16x32_bf16(Bt[n][k], At[m][k], acc[ai][bj][m][n], 0, 0, 0); } } \
        __builtin_amdgcn_s_setprio(0); } while (0)
#define G_WAIT_V(n) asm volatile("s_waitcnt vmcnt(" #n ")" ::: "memory")
#define G_WAIT_L(n) asm volatile("s_waitcnt lgkmcnt(" #n ")" ::: "memory")
#define G_BAR __builtin_amdgcn_s_barrier()
#define G_SCHED __builtin_amdgcn_sched_barrier(0)
#define G_LOAD_GOFF(ui_, hm_) do { const LAS unsigned* _rl = S.rowlist(ui_) + ((hm_) == 2 ? 128 : 0); const int _r1 = (hm_) ? 0 : 128; _Pragma("unroll") for (int _i = 0; _i < 2; ++_i) { int _R, _C; stage_rc(tid * 16 + _i * 8192, _R, _C); \
        goff[0][_i] = ((_rl[_R] >> 1) & 0x7fffu) * 1024u + (unsigned)(_C * 2); goff[1][_i] = ((_rl[_r1 + _R] >> 1) & 0x7fffu) * 1024u + (unsigned)(_C * 2); } } while (0)
    Unit cur, nxt; int ui = 0;
    if (!S.next(0, cur)) return;
    f32x4 acc[2][2][4][2];
#pragma unroll
    for (int a = 0; a < 2; ++a)
#pragma unroll
        for (int b = 0; b < 2; ++b)
#pragma unroll
            for (int m = 0; m < 4; ++m)
#pragma unroll
                for (int n = 0; n < 2; ++n) acc[a][b][m][n] = (f32x4){0.f, 0.f, 0.f, 0.f};
    bf16x8 At[4][2], B0[2][2], B1[2][2];
    const char* cA = cur.A; const char* cB = cur.B; const char* cB2 = nullptr; if constexpr (Sched::BSPLIT) cB2 = cur.B2;
    if constexpr (Sched::KJUMP) { nt = cur.nt; kjump = cur.kjump; }
    int hm = 0; if constexpr (Sched::HALFM) hm = cur.hm;
    if constexpr (Sched::GATHER) { G_LOAD_GOFF(0, hm); LDS_WAIT(); }
    G_STAGE_B(0, 0, cB); G_STAGE_A(0, 0, cA); G_STAGE_B(0, 1, cB); G_STAGE_A(0, 1, cA);
    if (wr == 1) G_BAR;
    G_WAIT_V(4); G_BAR;
    G_STAGE_B(1, 0, cB + kstepB); G_STAGE_A(1, 0, cA + kstepA); G_STAGE_B(1, 1, cB + kstepB);
    G_WAIT_V(6); G_BAR;
    for (;;) {
        const bool has_next = S.next(ui + 1, nxt);
        const char* nA = has_next ? nxt.A : cA; const char* nB = has_next ? nxt.B : cB;
        for (int t = 0; t < nt; t += 2) {
            const bool last = (t == nt - 2);
#define KO_(kt) ((long)((kt) + ((Sched::KJUMP && (kt) >= 4) ? kjump : 0)))
            const char* a1 = cA + KO_(t + 1) * kstepA;
            const bool c2 = Sched::BSPLIT && !last && KO_(t + 2) >= 8, c3 = Sched::BSPLIT && !last && KO_(t + 3) >= 8;
            const char* a2 = last ? nA : cA + KO_(t + 2) * kstepA; const char* b2 = last ? nB : (c2 ? cB2 + (KO_(t + 2) - 8) * kstepB : cB + KO_(t + 2) * kstepB);
            const char* a3 = last ? nA + kstepA : cA + KO_(t + 3) * kstepA; const char* b3 = last ? nB + kstepB : (c3 ? cB2 + (KO_(t + 3) - 8) * kstepB : cB + KO_(t + 3) * kstepB);
#undef KO_
            G_LDB(B0, 0, 0); G_SCHED; G_LDA(At, 0, 0); G_STAGE_A(1, 1, a1);
            G_WAIT_L(8); G_BAR; G_WAIT_L(0); G_MMA(0, 0, At, B0); G_BAR; G_SCHED;
            if constexpr (!Sched::HALFN) G_LDB(B1, 0, 1);
            G_STAGE_B2(0, 0, b2, c2);
            if constexpr (Sched::GATHER) { if (last && has_next) { G_LOAD_GOFF(ui + 1, nxt.hm); } }
            G_BAR; G_WAIT_L(0); if constexpr (!Sched::HALFN) G_MMA(0, 1, At, B1); G_BAR;
            if (!(Sched::HALFM && hm)) G_LDA(At, 0, 1);
            G_STAGE_A(0, 0, a2);
            G_BAR; G_WAIT_L(0); if (!(Sched::HALFM && hm)) G_MMA(1, 0, At, B0); G_BAR; G_SCHED;
            G_STAGE_B2(0, 1, b2, c2);
            G_WAIT_V(6); G_BAR; if constexpr (!Sched::HALFN) { if (!(Sched::HALFM && hm)) G_MMA(1, 1, At, B1); } G_BAR;
            G_LDB(B0, 1, 0); G_SCHED; G_LDA(At, 1, 0); G_STAGE_A(0, 1, a2);
            G_WAIT_L(8); G_BAR; G_WAIT_L(0); G_MMA(0, 0, At, B0); G_BAR; G_SCHED;
            if constexpr (!Sched::HALFN) G_LDB(B1, 1, 1);
            G_STAGE_B2(1, 0, b3, c3);
            G_BAR; G_WAIT_L(0); if constexpr (!Sched::HALFN) G_MMA(0, 1, At, B1); G_BAR;
            if (!(Sched::HALFM && hm)) G_LDA(At, 1, 1);
            G_STAGE_A(1, 0, a3);
            G_BAR; G_WAIT_L(0); if (!(Sched::HALFM && hm)) G_MMA(1, 0, At, B0); G_BAR; G_SCHED;
            G_STAGE_B2(1, 1, b3, c3);
            G_WAIT_V(6); G_BAR; if constexpr (!Sched::HALFN) { if (!(Sched::HALFM && hm)) G_MMA(1, 1, At, B1); } G_BAR;
        }
        if constexpr (ALIGN_EPI) { if (wr == 0) G_BAR; }
        if constexpr (Sched::FP8) asm volatile("s_nop 15\n\ts_nop 15" ::: "memory");
        E(acc, cur, wr, wc, fr, fq);
#ifdef PROBE_EPI2
        if constexpr (Epi::PERM || true) { asm volatile("" ::: "memory"); if (!Epi::NOTIDEM) E(acc, cur, wr, wc, fr, fq); }
#endif
        if (!has_next) break;
#pragma unroll
        for (int a = 0; a < 2; ++a)
#pragma unroll
            for (int b = 0; b < 2; ++b)
#pragma unroll
                for (int m = 0; m < 4; ++m)
#pragma unroll
                    for (int n = 0; n < 2; ++n) acc[a][b][m][n] = (f32x4){0.f, 0.f, 0.f, 0.f};
        cur = nxt; cA = nA; cB = nB; if constexpr (Sched::BSPLIT) cB2 = cur.B2; ++ui; if constexpr (Sched::KJUMP) { nt = cur.nt; kjump = cur.kjump; } if constexpr (Sched::HALFM) hm = cur.hm;
        if constexpr (ALIGN_EPI) { if (wr == 1) G_BAR; }
    }
    G_WAIT_V(0);
    if constexpr (!ALIGN_EPI) { if (wr == 0) G_BAR; }
    G_BAR;
#undef G_SA
#undef G_SB
#undef G_STAGE
#undef G_STAGE_A
#undef G_STAGE_B
#undef G_STAGE_B2
#undef G_LDA
#undef G_LDB
#undef G_MMA
#undef G_WAIT_V
#undef G_WAIT_L
#undef G_BAR
#undef G_SCHED
#undef G_LOAD_GOFF
}

template <int AMODE  , bool F8 = false  >
struct RegSched {
    static constexpr int PID = AMODE; static constexpr bool KJUMP = false, HALFN = false;
    static constexpr bool GATHER = false, FP8 = F8, HALFM = false, BSPLIT = false;
    int nt; long kstepA, kstepB, hstepA, hstepB;
    const char* A; const char* B; long tstepA, tstepB; unsigned pitchA, pitchB;
    int nM, nN, nwg, G, c;
    __device__ __forceinline__ unsigned voffA(int R, int C) const { return AMODE == 0 ? (unsigned)R * pitchA + (unsigned)C * 2u : (unsigned)(C >> 4) * (unsigned)(NTOK * 32) + (unsigned)R * 32u + (unsigned)((C >> 3) & 1) * 16u; }
    __device__ __forceinline__ unsigned voffB(int Rb, int C) const { return (unsigned)Rb * pitchB + (unsigned)C * 2u; }
    __device__ __forceinline__ const LAS unsigned* rowlist(int) const { return nullptr; }
    __device__ __forceinline__ void init(const void* A_, const void* B_, int N, int K, int G_, int c_) {
        constexpr int ES = F8 ? 1 : 2;
        A = (const char*)A_; B = (const char*)B_; nt = K * ES / (BK * 2); nM = NTOK / BM; nN = N / BM; nwg = nM * nN; G = G_; c = c_;
        pitchB = (unsigned)K * ES; kstepB = BK * 2; hstepB = (long)HALF * K * ES; tstepB = 2 * hstepB;
        if (AMODE == 0) { pitchA = (unsigned)K * ES; kstepA = BK * 2; hstepA = (long)HALF * K * ES; tstepA = 2 * hstepA; }
        else { pitchA = 32u; kstepA = 4l * NTOK * 32; hstepA = HALF * 32; tstepA = BM * 32; }
    }
    __device__ __forceinline__ bool next(int i, Unit& u) const {
        const long L = (long)i * G + c; if (L >= nwg) return false;
        int wgid = (int)L; { const int q = nwg / NXCD, r = nwg % NXCD, xcd = wgid % NXCD, off = wgid / NXCD; wgid = (xcd < r ? xcd * (q + 1) : r * (q + 1) + (xcd - r) * q) + off; }
        const int nig = WGM * nN, gid = wgid / nig, fm = gid * WGM, gsz = (nM - fm) < WGM ? (nM - fm) : WGM;
        const int pm = fm + ((wgid % nig) % gsz), pn = (wgid % nig) / gsz;
        u.A = A + (long)pm * tstepA; u.B = B + (long)pn * tstepB; u.p0 = pm; u.p1 = pn; u.p2 = 0; u.p3 = 0; return true;
    }
};
template <int MODE>
struct SsmSched {
    static constexpr int PID = 2 + MODE; static constexpr bool KJUMP = (MODE == 1), HALFN = (MODE == 0);
    static constexpr bool GATHER = false, FP8 = false, HALFM = false, BSPLIT = (MODE == 1);
    int nt; long kstepA, kstepB, hstepA, hstepB, hstepB2;
    const char* A; const char* B; const char* B2s; int G, vcu, lim;
    __device__ __forceinline__ unsigned voffA(int R, int C) const { return (unsigned)R * (UPITCH * 2) + (unsigned)C * 2u; }
    __device__ __forceinline__ unsigned voffB(int Rb, int C) const { return MODE == 0 ? (unsigned)Rb * 1024u + (unsigned)C * 2u : (unsigned)(Rb & 15) * 2048u + (unsigned)(7 - (Rb >> 4)) * 32u + (unsigned)C * 2u; }
    __device__ __forceinline__ unsigned voffB2(int Rb, int C) const { return (unsigned)Rb * 256u + (unsigned)C * 2u; }
    __device__ __forceinline__ const LAS unsigned* rowlist(int) const { return nullptr; }
    __device__ __forceinline__ void init(const void* A_, const void* B_, int G_, int vcu_) {
        A = (const char*)A_; B = (const char*)B_; B2s = nullptr; G = G_; vcu = vcu_; lim = 1 << 20; kstepA = 128; kstepB = 128; hstepA = 128l * UPITCH * 2; hstepB2 = 128l * 256;
        if (MODE == 0) { nt = 8; hstepB = 0; } else { nt = 10; hstepB = -256; }
    }
    __device__ __forceinline__ bool next(int i, Unit& u) const {
        const int L = i * G + vcu;
        if (i >= lim) return false;
        if (MODE == 0) { if (L >= NGRP * 4) return false; const int g = L >> 2, pm = L & 3;
            u.A = A + ((long)g * NCH + pm * 256) * (UPITCH * 2); u.B = B + (long)g * (128 * 1024); u.p0 = g; u.p1 = pm; u.p2 = 0; u.p3 = 0; return true; }
        if (L >= NGRP * 8) return false; const int g = L >> 3, pm = (L >> 1) & 3, pn = (L ^ i) & 1;
        u.A = A + ((long)g * NCH + pm * 256) * (UPITCH * 2); u.B = B + (long)g * (16 * 2048) + (24 - 16 * pn) * 32; u.B2 = B2s + ((long)g * 512 + pn * 256) * 256l; u.p0 = g; u.p1 = pm; u.p2 = pn; u.p3 = 0;
        u.nt = pn == 0 ? 6 : 10; u.kjump = pn == 0 ? 4 : 0; return true;
    }
};
struct UnitRec { int e, rt, tg, pn; };
template <int MODE>
struct MoeSched {
    static constexpr int PID = 4 + MODE; static constexpr bool KJUMP = false, HALFN = false;
    static constexpr bool GATHER = (MODE == 0), FP8 = true, HALFM = true, BSPLIT = false;
    int nt; long kstepA, kstepB, hstepA, hstepB;
    const char* A; const char* B; const LAS UnitRec* ut; const LAS unsigned* lists; int nunits;
    __device__ __forceinline__ unsigned voffA(int R, int C) const { return (unsigned)R * 512u + (unsigned)C * 2u; }
    __device__ __forceinline__ unsigned voffB(int Rb, int C) const { return (unsigned)Rb * (MODE == 0 ? 1024u : 512u) + (unsigned)C * 2u; }
    __device__ __forceinline__ const LAS unsigned* rowlist(int ui) const { return lists + ui * 512; }
    __device__ __forceinline__ void init(const void* A_, const void* B_, const LAS UnitRec* ut_, const LAS unsigned* lists_, int nunits_) {
        A = (const char*)A_; B = (const char*)B_; ut = ut_; lists = lists_; nunits = nunits_; kstepA = 128; kstepB = 128;
        if (MODE == 0) { nt = 8; hstepA = 0; hstepB = 128l * 1024; } else { nt = 4; hstepA = 128l * 512; hstepB = 128l * 512; }
    }
    __device__ __forceinline__ bool next(int i, Unit& u) const {
        if (i >= nunits) return false;
        const int e = __builtin_amdgcn_readfirstlane(ut[i].e), tg = __builtin_amdgcn_readfirstlane(ut[i].tg), pnh = __builtin_amdgcn_readfirstlane(ut[i].pn), pn = pnh & 255, hm = pnh >> 8;
        if (MODE == 0) { u.A = A; u.B = B + ((long)e * 4 + pn) * (256l * 1024); }
        else { u.A = A + ((long)tg * 256 + (hm == 2 ? 128 : 0)) * 512l; u.B = B + ((long)e * 1024 + pn * 256) * 512l; }
        u.p0 = tg; u.p1 = pn; u.p2 = i; u.p3 = e; u.hm = hm; return true;
    }
};

typedef f32x4 AccT[2][2][4][2];
#define EPI_LOOP_AIM for (int ai = 0; ai < 2; ++ai) _Pragma("unroll") for (int m = 0; m < 4; ++m)
struct EpiInproj { static constexpr bool NOTIDEM = false; static constexpr bool PERM = true, PERM2 = false; bf16* UG;
    __device__ __forceinline__ void operator()(const AccT& acc, const Unit& u, int wr, int wc, int fr, int fq) const {
#pragma unroll
        EPI_LOOP_AIM { const int tok = u.p0 * 256 + ai * 128 + wr * 64 + m * 16 + fr;
#pragma unroll
            for (int bj = 0; bj < 2; ++bj) { const int g = u.p1 * 16 + bj * 8 + wc * 2 + (fq >> 1);
                bf16* dst = UG + ((size_t)g * NCH + (tok >> 5)) * UPITCH + (tok & 31) * 16 + (fq & 1) * 8;
                const f32x4 v0 = acc[ai][bj][m][0], v1 = acc[ai][bj][m][1];
                v4u w; w.x = cvt_pk_bf16(v0[0], v0[1]); w.y = cvt_pk_bf16(v0[2], v0[3]); w.z = cvt_pk_bf16(v1[0], v1[1]); w.w = cvt_pk_bf16(v1[2], v1[3]); *(v4u*)dst = w; } }
    } };
struct EpiS1 { static constexpr bool NOTIDEM = false; static constexpr bool PERM = true, PERM2 = false; bf16* SB;
    __device__ __forceinline__ void operator()(const AccT& acc, const Unit& u, int wr, int wc, int fr, int fq) const {
#pragma unroll
        EPI_LOOP_AIM { const int row = u.p1 * 256 + ai * 128 + wr * 64 + m * 16 + fr; bf16* dst = SB + ((size_t)u.p0 * NCH + row) * 128 + wc * 32 + 8 * fq;
            const f32x4 v0 = acc[ai][0][m][0], v1 = acc[ai][0][m][1];
            v4u w; w.x = cvt_pk_bf16(v0[0], v0[1]); w.y = cvt_pk_bf16(v0[2], v0[3]); w.z = cvt_pk_bf16(v1[0], v1[1]); w.w = cvt_pk_bf16(v1[2], v1[3]); *(v4u*)dst = w; }
    } };
struct EpiY { static constexpr bool NOTIDEM = false; static constexpr bool PERM = true, PERM2 = false; bf16* GG;
    __device__ __forceinline__ void operator()(const AccT& acc, const Unit& u, int wr, int wc, int fr, int fq) const {
#pragma unroll
        EPI_LOOP_AIM { const int row = u.p1 * 256 + ai * 128 + wr * 64 + m * 16 + fr; bf16* dst = GG + ((size_t)u.p0 * NCH + row) * 512 + u.p2 * 256 + wc * 32 + 8 * fq;
#pragma unroll
            for (int bj = 0; bj < 2; ++bj) { const f32x4 v0 = acc[ai][bj][m][0], v1 = acc[ai][bj][m][1];
                v4u w; w.x = cvt_pk_bf16(gelu_tanh(v0[0]), gelu_tanh(v0[1])); w.y = cvt_pk_bf16(gelu_tanh(v0[2]), gelu_tanh(v0[3]));
                w.z = cvt_pk_bf16(gelu_tanh(v1[0]), gelu_tanh(v1[1])); w.w = cvt_pk_bf16(gelu_tanh(v1[2]), gelu_tanh(v1[3])); *(v4u*)(dst + bj * 128) = w; } }
    } };
struct EpiGlu { static constexpr bool PERM = true, PERM2 = false; const float* X0; bf16* XO; const float* gate1;
    __device__ __forceinline__ void operator()(const AccT& acc, const Unit& u, int wr, int wc, int fr, int fq) const {
        const int b = u.p0 >> 6, col0 = u.p1 * 128 + wc * 32 + 8 * fq;
        const size_t off0 = (size_t)(u.p0 * 256 + wr * 64 + fr) * D + col0;
        f32x4 xv[2][4][2];
#pragma unroll
        for (int ai = 0; ai < 2; ++ai)
#pragma unroll
            for (int m = 0; m < 4; ++m)
#pragma unroll
                for (int n = 0; n < 2; ++n) xv[ai][m][n] = __builtin_nontemporal_load((const f32x4*)(X0 + off0 + (size_t)(ai * 128 + m * 16) * D + n * 4));
        f32x4 gv[2];
#pragma unroll
        for (int n = 0; n < 2; ++n) { gv[n] = *(const f32x4*)(gate1 + b * 6144 + col0 + n * 4); gv[n] = gv[n] + 1.0f; }
#pragma unroll
        EPI_LOOP_AIM { float o[8];
#pragma unroll
            for (int n = 0; n < 2; ++n) { const f32x4 va = acc[ai][0][m][n], ga = acc[ai][1][m][n];
#pragma unroll
                for (int j = 0; j < 4; ++j) o[n * 4 + j] = xv[ai][m][n][j] + gv[n][j] * va[j] * sigmoidf_(ga[j]); }
            v4u w; w.x = cvt_pk_bf16(o[0], o[1]); w.y = cvt_pk_bf16(o[2], o[3]); w.z = cvt_pk_bf16(o[4], o[5]); w.w = cvt_pk_bf16(o[6], o[7]);
            *(v4u*)(XO + off0 + (size_t)(ai * 128 + m * 16) * D) = w; }
    } };
struct EpiCV { static constexpr bool NOTIDEM = false; static constexpr bool PERM = true, PERM2 = false; bf16* UU;
    __device__ __forceinline__ void operator()(const AccT& acc, const Unit& u, int wr, int wc, int fr, int fq) const {
#pragma unroll
        EPI_LOOP_AIM { bf16* dst = UU + (size_t)(u.p0 * 256 + ai * 128 + wr * 64 + m * 16 + fr) * D + u.p1 * 128 + wc * 32 + 8 * fq;
            const f32x4 c0 = acc[ai][0][m][0], c1 = acc[ai][0][m][1], v0 = acc[ai][1][m][0], v1 = acc[ai][1][m][1];
            v4u w; w.x = cvt_pk_bf16(c0[0] * v0[0], c0[1] * v0[1]); w.y = cvt_pk_bf16(c0[2] * v0[2], c0[3] * v0[3]); w.z = cvt_pk_bf16(c1[0] * v1[0], c1[1] * v1[1]); w.w = cvt_pk_bf16(c1[2] * v1[2], c1[3] * v1[3]);
            *(v4u*)dst = w; }
    } };
struct EpiBf16 { static constexpr bool NOTIDEM = false; static constexpr bool PERM = true, PERM2 = false; bf16* O; int ldc;
    __device__ __forceinline__ void operator()(const AccT& acc, const Unit& u, int wr, int wc, int fr, int fq) const {
#pragma unroll
        EPI_LOOP_AIM { bf16* dst = O + (size_t)(u.p0 * 256 + ai * 128 + wr * 64 + m * 16 + fr) * ldc + u.p1 * 256 + wc * 32 + 8 * fq;
#pragma unroll
            for (int bj = 0; bj < 2; ++bj) { const f32x4 v0 = acc[ai][bj][m][0], v1 = acc[ai][bj][m][1];
                v4u w; w.x = cvt_pk_bf16(v0[0], v0[1]); w.y = cvt_pk_bf16(v0[2], v0[3]); w.z = cvt_pk_bf16(v1[0], v1[1]); w.w = cvt_pk_bf16(v1[2], v1[3]); *(v4u*)(dst + bj * 128) = w; } }
    } };
struct EpiResid { static constexpr bool PERM = true, PERM2 = false; bf16* X; const float* gate1;
    __device__ __forceinline__ void operator()(const AccT& acc, const Unit& u, int wr, int wc, int fr, int fq) const {
        const int b = u.p0 >> 6, col0 = u.p1 * 256 + wc * 32 + 8 * fq;
        bf16* base = X + (size_t)(u.p0 * 256 + wr * 64 + fr) * D + col0;
        f32x4 gv[2][2];
#pragma unroll
        for (int bj = 0; bj < 2; ++bj)
#pragma unroll
            for (int n = 0; n < 2; ++n) { gv[bj][n] = *(const f32x4*)(gate1 + b * 6144 + col0 + bj * 128 + n * 4); gv[bj][n] = (gv[bj][n] + 1.0f) * (1.0f / (FS_A3 * FS_WCO)); }
#pragma unroll
        for (int ai = 0; ai < 2; ++ai) {
            v4u xq[4][2];
#pragma unroll
            for (int m = 0; m < 4; ++m)
#pragma unroll
                for (int bj = 0; bj < 2; ++bj) xq[m][bj] = *(const v4u*)(base + (size_t)(ai * 128 + m * 16) * D + bj * 128);
#pragma unroll
            for (int m = 0; m < 4; ++m) { bf16* rowp = base + (size_t)(ai * 128 + m * 16) * D;
#pragma unroll
                for (int bj = 0; bj < 2; ++bj) { const v4u q = xq[m][bj]; const f32x4 a0 = acc[ai][bj][m][0], a1 = acc[ai][bj][m][1];
                    v4u w; w.x = cvt_pk_bf16(bf_lo(q.x) + gv[bj][0][0] * a0[0], bf_hi(q.x) + gv[bj][0][1] * a0[1]); w.y = cvt_pk_bf16(bf_lo(q.y) + gv[bj][0][2] * a0[2], bf_hi(q.y) + gv[bj][0][3] * a0[3]);
                    w.z = cvt_pk_bf16(bf_lo(q.z) + gv[bj][1][0] * a1[0], bf_hi(q.z) + gv[bj][1][1] * a1[1]); w.w = cvt_pk_bf16(bf_lo(q.w) + gv[bj][1][2] * a1[2], bf_hi(q.w) + gv[bj][1][3] * a1[3]);
                    *(v4u*)(rowp + bj * 128) = w; } }
            asm volatile("" ::: "memory"); }
    } };
struct EpiMoe1 { static constexpr bool NOTIDEM = false; static constexpr bool PERM = true, PERM2 = false; unsigned char* HB;
    __device__ __forceinline__ void operator()(const AccT& acc, const Unit& u, int wr, int wc, int fr, int fq) const {
        constexpr float IA = 1.0f / (FS_XN * FS_W13), IB = FS_H / (FS_XN * FS_W13);
        const int roff = u.hm == 2 ? 128 : 0;
#pragma unroll
        for (int ai = 0; ai < 2; ++ai) if (!(ai && u.hm)) _Pragma("unroll") for (int m = 0; m < 4; ++m) { unsigned char* dst = HB + ((size_t)u.p0 * 256 + roff + ai * 128 + wr * 64 + m * 16 + fr) * DEXP + u.p1 * 128 + wc * 32 + 8 * fq;
            const f32x4 a0 = acc[ai][0][m][0] * IA, a1 = acc[ai][0][m][1] * IA, b0 = acc[ai][1][m][0] * IB, b1 = acc[ai][1][m][1] * IB; float h[8];
#pragma unroll
            for (int j = 0; j < 4; ++j) { h[j] = sat_fp8(a0[j] * sigmoidf_(a0[j]) * b0[j]); h[4 + j] = sat_fp8(a1[j] * sigmoidf_(a1[j]) * b1[j]); }
            v2u w; w.x = pk4_fp8(h[0], h[1], h[2], h[3]); w.y = pk4_fp8(h[4], h[5], h[6], h[7]); *(v2u*)dst = w; }
    } };
struct EpiMoe2 { static constexpr bool NOTIDEM = false; static constexpr bool PERM = true, PERM2 = true; unsigned char* O2; const LAS unsigned* lists;
    __device__ __forceinline__ void operator()(const AccT& acc, const Unit& u, int wr, int wc, int fr, int fq) const {
        const LAS unsigned* sl = lists + u.p2 * 512;
        const int fr_ = fresh_lane() & 15;
        const int roff = u.hm == 2 ? 128 : 0;
#pragma unroll
        for (int ai = 0; ai < 2; ++ai) if (!(ai && u.hm)) _Pragma("unroll") for (int m = 0; m < 4; ++m) { const int r = roff + ai * 128 + wr * 64 + m * 16 + fr_; const unsigned slot = sl[r]; const float wt = __builtin_bit_cast(float, sl[256 + r]) * (FS_O / (FS_H * FS_W2));
            if (slot != 0xffffffffu) { unsigned char* dst = O2 + (size_t)slot * D + u.p1 * 256 + wc * 64 + 16 * fq; unsigned w4[4];
#pragma unroll
                for (int bj = 0; bj < 2; ++bj)
#pragma unroll
                    for (int n = 0; n < 2; ++n) { const f32x4 v = acc[ai][bj][m][n] * wt; w4[bj * 2 + n] = pk4_fp8(sat_fp8(v[0]), sat_fp8(v[1]), sat_fp8(v[2]), sat_fp8(v[3])); }
                v4u w; w.x = w4[0]; w.y = w4[1]; w.z = w4[2]; w.w = w4[3]; *(v4u*)dst = w; } }
    } };
}

enum { I_X = 0, I_C, I_ADAW, I_ADAB, I_N1G, I_N2G, I_SWIN, I_LRE, I_LIM, I_LDT, I_BRE, I_BIM, I_CRE, I_CIM, I_SD, I_SWGLU, I_CWIN, I_CW, I_CWOUT, I_WG, I_BGB, I_WE, I_BEB, I_W1, I_W3, I_W2, I_FG };
constexpr int NPH = 18;

template <bool FP8 = false, class RowPtr>
__device__ __forceinline__ void transpose_item(const float* W, int ldw, int k0, int n0, RowPtr rp, LAS float* scr, int lane, float fs = 1.0f) {
    float v[64];
    const float* src = W + (size_t)k0 * ldw + n0 + lane;
#pragma unroll
    for (int i = 0; i < 64; ++i) v[i] = __builtin_nontemporal_load(src + (size_t)i * ldw);
#pragma unroll
    for (int i = 0; i < 64; ++i) scr[i * 65 + lane] = v[i];
    LDS_WAIT(); asm volatile("" ::: "memory");
    const int c = lane & 7;
#pragma unroll
    for (int j = 0; j < 8; ++j) { const int n = (lane >> 3) + 8 * j; const LAS float* s = scr + (8 * c) * 65 + n;
        if constexpr (FP8) { v2u o; o.x = pk4_fp8(s[0 * 65] * fs, s[1 * 65] * fs, s[2 * 65] * fs, s[3 * 65] * fs); o.y = pk4_fp8(s[4 * 65] * fs, s[5 * 65] * fs, s[6 * 65] * fs, s[7 * 65] * fs);
            __builtin_nontemporal_store(o, (v2u*)(rp(n0 + n) + k0 + 8 * c)); }
        else { v4u o; o.x = pk2(s[0 * 65], s[1 * 65]); o.y = pk2(s[2 * 65], s[3 * 65]); o.z = pk2(s[4 * 65], s[5 * 65]); o.w = pk2(s[6 * 65], s[7 * 65]);
            __builtin_nontemporal_store(o, (v4u*)(rp(n0 + n) + k0 + 8 * c)); } }
    LDS_WAIT(); asm volatile("" ::: "memory");
}
constexpr int MOE_WITEMS = 12288;
__device__ __forceinline__ void moe_weight_item(const KArgs a, unsigned char* ws, int id, int le_base, LAS float* scr, int lane) {
    unsigned char* W13 = ws + WS_W13 + (size_t)(le_base >> 5) * (64 * MiB); unsigned char* W2T = ws + WS_W2 + (size_t)(le_base >> 5) * (32 * MiB);
    const int which = id >> 12, r = id & 4095, e = r >> 7, le = le_base + e;
    if (which < 2) { const int kb = (r >> 3) & 15, nb = r & 7;
        transpose_item<true>(a.in(which ? I_W3 : I_W1) + (size_t)le * 1024 * 512, 512, kb * 64, nb * 64, [&](int n) { return W13 + ((size_t)e * 1024 + (n >> 7) * 256 + which * 128 + (n & 127)) * 1024; }, scr, lane, FS_W13); }
    else { const int kb = (r >> 4) & 7, nb = r & 15;
        transpose_item<true>(a.in(I_W2) + (size_t)le * 512 * 1024, 1024, kb * 64, nb * 64, [&](int n) { return W2T + ((size_t)e * 1024 + n) * 512; }, scr, lane, FS_W2); }
}
constexpr int DEF_A = 2048, DEF_QB = 16, DEF_QC = 8;
__device__ __forceinline__ void deferred_items(const KArgs a, LAS unsigned char* lds, int first, int count, int slot, int nslots, int wave) {
    unsigned char* ws = a.ws(); LAS float* scr = (LAS float*)(lds + wave * 16640);
    const int lane = fresh_lane();
    for (int id = first + slot; id < first + count && id < MOE_WITEMS; id += nslots) moe_weight_item(a, ws, id, 32, scr, lane);
}
__device__ __forceinline__ void light_info(int P, int G, int bx, int& L, int& rank) {
    L = 0; rank = -1; if (G != 256) return;
    int nmax = 0;
    for (int x = 0; x < 8; ++x) { const int nx = 4 * (((x + 1) * P) / 8 - (x * P) / 8); const int rem = nx & 31; const int m = 2 * (nx >> 5) + (rem == 0 ? 0 : (rem <= 16 ? 1 : 2)); nmax = m > nmax ? m : nmax; }
    const int mx = bx & 7, mj = bx >> 3;
    for (int x = 0; x < 8; ++x) { const int nx = 4 * (((x + 1) * P) / 8 - (x * P) / 8); const int rem = nx & 31; const int m = 2 * (nx >> 5) + (rem == 0 ? 0 : (rem <= 16 ? 1 : 2));
        const int first_light = (m < nmax) ? 0 : (rem == 0 ? 32 : (rem <= 16 ? 2 * rem : rem));
        if (x == mx && mj >= first_light) rank = L + (mj - first_light);
        L += 32 - first_light; }
}
struct Cplx { float re, im; };
__device__ __forceinline__ Cplx lam_pow(float lr, float li, float dt, int tau) {
    const float mag = expf(lr * dt * (float)tau);
    const double ang = (double)li * (double)dt * (double)tau;
    const double nrev = __builtin_rint(ang * 0.15915494309189535);
    const float r = (float)(ang - nrev * 6.283185307179586);
    Cplx e; e.re = mag * cosf(r); e.im = mag * sinf(r); return e;
}
__device__ __forceinline__ float reduce16(const float (&v)[16], int lane) {
    float a[8], b[4], c[2], d;
    const bool b5 = lane & 32, b4 = lane & 16, b3 = lane & 8, b2 = lane & 4;
#pragma unroll
    for (int i = 0; i < 8; ++i) { const float keep = b5 ? v[2 * i + 1] : v[2 * i], send = b5 ? v[2 * i] : v[2 * i + 1]; a[i] = keep + shx(send, 32, lane); }
#pragma unroll
    for (int i = 0; i < 4; ++i) { const float keep = b4 ? a[2 * i + 1] : a[2 * i], send = b4 ? a[2 * i] : a[2 * i + 1]; b[i] = keep + shx(send, 16, lane); }
#pragma unroll
    for (int i = 0; i < 2; ++i) { const float keep = b3 ? b[2 * i + 1] : b[2 * i], send = b3 ? b[2 * i] : b[2 * i + 1]; c[i] = keep + shx(send, 8, lane); }
    { const float keep = b2 ? c[1] : c[0], send = b2 ? c[0] : c[1]; d = keep + shx(send, 4, lane); }
    d += shx(d, 2, lane); d += shx(d, 1, lane);
    return d;
}

__device__ __forceinline__ void p0_prologue(const KArgs a, LAS unsigned char* lds, int vcu, int G, int tid, int lane, int wave) {
    unsigned char* ws = a.ws();
    asm volatile("" : "+v"(tid)); lane = tid & 63;
    {
        LAS float* cond = (LAS float*)lds; LAS float* part = cond + 2048;
        __syncthreads();
        for (int i = tid; i < 2048; i += 512) { const float c = a.in(I_C)[i]; cond[i] = c / (1.0f + expf(-c)); }
        __syncthreads();
        float* mod = (float*)(ws + WS_MOD);
        for (int task = vcu; task < 256; task += G) {
            const int l = task >> 7, nb = task & 127;
            const float* W = a.in(I_ADAW) + (size_t)l * 1024 * 6144 + nb * 48 + (lane < 48 ? lane : 0);
            float a0 = 0.f, a1 = 0.f;
#pragma unroll 32
            for (int k = wave * 128; k < wave * 128 + 128; ++k) { const float w = __builtin_nontemporal_load(W + (size_t)k * 6144); a0 += cond[k] * w; a1 += cond[1024 + k] * w; }
            if (lane < 48) { part[(wave * 2 + 0) * 48 + lane] = a0; part[(wave * 2 + 1) * 48 + lane] = a1; }
            __syncthreads();
            if (tid < 96) { const int b = tid / 48, j = tid % 48; float s = 0.f;
#pragma unroll
                for (int w = 0; w < 8; ++w) s += part[(w * 2 + b) * 48 + j];
                const int n = nb * 48 + j; mod[(l * 2 + b) * 6144 + n] = s + a.in(I_ADAB)[l * 6144 + n]; }
            __syncthreads();
        }
    }
    LAS float* scr = (LAS float*)(lds + wave * 16640);
    const int gw = vcu * NWAVES + wave, NGW = G * NWAVES;
    bf16* WIN = (bf16*)(ws + WS_WIN); bf16* WGLU = (bf16*)(ws + WS_WGLU); bf16* WCIN = (bf16*)(ws + WS_WCIN); bf16* WCOUT = (bf16*)(ws + WS_WCOUT);
    bf16* BM_ = (bf16*)(ws + WS_BM); bf16* BT = (bf16*)(ws + WS_BT); bf16* CM_ = (bf16*)(ws + WS_CM); float* SC = (float*)(ws + WS_SC);
    constexpr int I0 = 256, I1 = 512, I2 = 768, I3 = 256, I4 = MOE_WITEMS, I7 = NGRP * 63, I8 = NGRP * 32, I9 = NGRP * 32, I10 = NGRP, I11 = 96;
    constexpr int NITEMS = I0 + I1 + I2 + I3 + I4 + I7 + I8 + I9 + I10 + I11;
    for (int it = gw; it < NITEMS; it += NGW) {
        int r = it;
        if (r < I0) { const int kb = r >> 4, nb = r & 15; transpose_item(a.in(I_SWIN), 1024, kb * 64, nb * 64, [&](int n) { return WIN + (size_t)n * 1024; }, scr, lane); continue; } r -= I0;
        if (r < I1) { const int kb = r >> 5, nb = r & 31;
            transpose_item(a.in(I_SWGLU), 2048, kb * 64, nb * 64, [&](int n) { const int half = n >> 10, nn = n & 1023; return WGLU + (size_t)((nn >> 7) * 256 + half * 128 + (nn & 127)) * 1024; }, scr, lane); continue; } r -= I1;
        if (r < I2) { const int kb = r / 48, nb = r % 48;
            transpose_item(a.in(I_CWIN), 3072, kb * 64, nb * 64, [&](int n) { const int part = n >> 10, nn = n & 1023;
                const int row = part == 0 ? 2048 + nn : (nn >> 7) * 256 + (part - 1) * 128 + (nn & 127); return WCIN + (size_t)row * 1024; }, scr, lane); continue; } r -= I2;
        if (r < I3) { const int kb = r >> 4, nb = r & 15; transpose_item<true>(a.in(I_CWOUT), 1024, kb * 64, nb * 64, [&](int n) { return (unsigned char*)WCOUT + (size_t)n * 1024; }, scr, lane, FS_WCO); continue; } r -= I3;
        if (r < I4) { moe_weight_item(a, ws, r, 0, scr, lane); continue; } r -= I4;
        if (r >= I7 + I8 + I9 + I10) {
            r -= I7 + I8 + I9 + I10; const int l = r / 48, n = r % 48; bf16* hrow = (bf16*)(ws + WS_WR) + ((size_t)(l * 2) * 48 + n) * 1024; bf16* lrow = hrow + 48 * 1024;
            for (int i = 0; i < 16; ++i) { const int k = lane + 64 * i; const float w = n < 4 ? a.in(I_WG)[((size_t)l * 1024 + k) * 4 + n] : (n < 36 ? a.in(I_WE)[((size_t)l * 1024 + k) * 32 + n - 4] : 0.f);
                const unsigned hb = f2bf(w); hrow[k] = (bf16)hb; lrow[k] = (bf16)f2bf(w - __builtin_bit_cast(float, hb << 16)); }
            continue; }
        int g, sub, kind;
        if (r < I7) { kind = 0; g = r / 63; sub = r % 63 - 31; } else { r -= I7; if (r < I8) { kind = 1; g = r >> 5; sub = r & 31; } else { r -= I8; if (r < I9) { kind = 2; g = r >> 5; sub = r & 31; } else { r -= I9; kind = 3; g = r; sub = 0; } } }
        const int p = lane;
        float crv[16], civ[16];
        if (kind == 0 && sub >= 0) {
#pragma unroll
            for (int s = 0; s < 16; ++s) { crv[s] = a.in(I_CRE)[(g * 16 + (lane & 15)) * 64 + 4 * s + (lane >> 4)]; civ[s] = a.in(I_CIM)[(g * 16 + (lane & 15)) * 64 + 4 * s + (lane >> 4)]; } }
        else if (kind == 1) {
#pragma unroll
            for (int k = 0; k < 16; ++k) { crv[k] = a.in(I_CRE)[(g * 16 + k) * 64 + p]; civ[k] = a.in(I_CIM)[(g * 16 + k) * 64 + p]; } }
        else {
#pragma unroll
            for (int k = 0; k < 16; ++k) { crv[k] = 0.f; civ[k] = 0.f; } }
        const float lr = a.in(I_LRE)[g * 64 + p], li = a.in(I_LIM)[g * 64 + p], dt = expf(a.in(I_LDT)[g]);
        if (kind == 3) { const Cplx e = lam_pow(lr, li, dt, LC); SC[(g * 64 + p) * 2] = e.re; SC[(g * 64 + p) * 2 + 1] = e.im; continue; }
        if (kind == 1) {
            const Cplx e = lam_pow(lr, li, dt, sub + 1);
#pragma unroll
            for (int k = 0; k < 16; ++k) { const float cr = crv[k], ci = civ[k];
                bf16* row = CM_ + ((size_t)g * 512 + sub * 16 + k) * 128; row[p] = (bf16)f2bf(cr * e.re - ci * e.im); row[64 + p] = (bf16)f2bf(-(cr * e.im + ci * e.re)); }
            continue; }
        const Cplx ab = lam_pow(lr, li, dt, 1);
        const float den = lr * lr + li * li, cfr = ((ab.re - 1.0f) * lr + ab.im * li) / den, cfi = (ab.im * lr - (ab.re - 1.0f) * li) / den;
        if (kind == 0 && sub < 0) {
            if (lane < 32) { const int k = (lane >> 1) & 15, half = lane & 1; *(v4u*)(BT + ((size_t)g * 16 + k) * 1024 + (31 - sub) * 16 + half * 8) = (v4u){0u, 0u, 0u, 0u}; }
            continue; }
        const Cplx e = lam_pow(lr, li, dt, kind == 0 ? sub : (LC - 1 - sub));
        float wre[16], wim[16];
        { const f32x4* brp = (const f32x4*)(a.in(I_BRE) + (size_t)(g * 64 + p) * 16); const f32x4* bip = (const f32x4*)(a.in(I_BIM) + (size_t)(g * 64 + p) * 16);
#pragma unroll
            for (int q = 0; q < 4; ++q) { const f32x4 br = brp[q], bi = bip[q];
#pragma unroll
                for (int j = 0; j < 4; ++j) { const float bbr = cfr * br[j] - cfi * bi[j], bbi = cfr * bi[j] + cfi * br[j]; wre[q * 4 + j] = e.re * bbr - e.im * bbi; wim[q * 4 + j] = e.re * bbi + e.im * bbr; } } }
        if (kind == 2) {
            bf16* r0 = BM_ + ((size_t)g * 128 + p) * 512 + sub * 16; bf16* r1 = r0 + 64 * 512;
            v4u o; o.x = pk2(wre[0], wre[1]); o.y = pk2(wre[2], wre[3]); o.z = pk2(wre[4], wre[5]); o.w = pk2(wre[6], wre[7]); *(v4u*)r0 = o;
            o.x = pk2(wre[8], wre[9]); o.y = pk2(wre[10], wre[11]); o.z = pk2(wre[12], wre[13]); o.w = pk2(wre[14], wre[15]); *(v4u*)(r0 + 8) = o;
            o.x = pk2(wim[0], wim[1]); o.y = pk2(wim[2], wim[3]); o.z = pk2(wim[4], wim[5]); o.w = pk2(wim[6], wim[7]); *(v4u*)r1 = o;
            o.x = pk2(wim[8], wim[9]); o.y = pk2(wim[10], wim[11]); o.z = pk2(wim[12], wim[13]); o.w = pk2(wim[14], wim[15]); *(v4u*)(r1 + 8) = o;
            continue; }
        {
#pragma unroll
            for (int q = 0; q < 4; ++q) { *(LAS f32x4*)(scr + p * 16 + 4 * q) = (f32x4){wre[4 * q], wre[4 * q + 1], wre[4 * q + 2], wre[4 * q + 3]};
                *(LAS f32x4*)(scr + 1024 + p * 16 + 4 * q) = (f32x4){wim[4 * q], wim[4 * q + 1], wim[4 * q + 2], wim[4 * q + 3]}; }
            LDS_WAIT(); asm volatile("" ::: "memory");
            const int kq = lane & 15, pq = lane >> 4;
            f32x4 acc = (f32x4){0.f, 0.f, 0.f, 0.f};
#pragma unroll
            for (int s = 0; s < 16; ++s) { const float wr = scr[(4 * s + pq) * 16 + kq], wi = scr[1024 + (4 * s + pq) * 16 + kq];
                acc = __builtin_amdgcn_mfma_f32_16x16x4f32(crv[s], wr, acc, 0, 0, 0); acc = __builtin_amdgcn_mfma_f32_16x16x4f32(-civ[s], wi, acc, 0, 0, 0); }
#pragma unroll
            for (int r_ = 0; r_ < 4; ++r_) { const int k = 4 * pq + r_; float m = acc[r_]; if (sub == 0 && k == kq) m += a.in(I_SD)[g * 16 + k];
                BT[((size_t)g * 16 + k) * 1024 + (31 - sub) * 16 + kq] = (bf16)f2bf(m); }
            LDS_WAIT(); asm volatile("" ::: "memory");
        }
    }
}

__device__ __forceinline__ void unpack8(const v4u q, float (&f)[8]) { f[0] = bf_lo(q.x); f[1] = bf_hi(q.x); f[2] = bf_lo(q.y); f[3] = bf_hi(q.y); f[4] = bf_lo(q.z); f[5] = bf_hi(q.z); f[6] = bf_lo(q.w); f[7] = bf_hi(q.w); }
__device__ __forceinline__ v4u pack8(const float (&f)[8]) { v4u o; o.x = pk2(f[0], f[1]); o.y = pk2(f[2], f[3]); o.z = pk2(f[4], f[5]); o.w = pk2(f[6], f[7]); return o; }
template <bool COMBINE, bool FINAL, bool XF32  >
__device__ __forceinline__ void norm_phase(const KArgs a, LAS unsigned char* lds, int vcu, int G, int tid, int lane, int wave,
                                           const void* xin, bf16* xio, float* outf, const float* gain, const float* modl  , int sh_idx  ,
                                           const float* modprev  ) {
    unsigned char* ws = a.ws();
    asm volatile("" : "+v"(tid)); lane = tid & 63;
    bf16* XN = (bf16*)(ws + WS_XN); const unsigned char* O2 = ws + WS_O2;
    constexpr int RPI = (COMBINE || XF32) ? 2 : 4, NIT = 16 / RPI;
    for (int blk = vcu; blk < NTOK / 128; blk += G) {
        const int b = (blk * 128) >> 14;
        float gmv[2][8], shv[2][8], ggv[2][8];
#pragma unroll
        for (int j = 0; j < 2; ++j)
#pragma unroll
            for (int h = 0; h < 2; ++h) { const int c = 512 * j + 8 * lane + 4 * h; const f32x4 gn = *(const f32x4*)(gain + c); f32x4 gmq, shq;
                if constexpr (FINAL) { gmq = gn; shq = (f32x4){0.f, 0.f, 0.f, 0.f}; }
                else { const f32x4 sc = *(const f32x4*)(modl + b * 6144 + (sh_idx + 1) * 1024 + c); gmq = gn * (sc + 1.0f); shq = *(const f32x4*)(modl + b * 6144 + sh_idx * 1024 + c); }
#pragma unroll
                for (int q = 0; q < 4; ++q) { gmv[j][4 * h + q] = gmq[q]; shv[j][4 * h + q] = shq[q]; }
                if constexpr (COMBINE) { const f32x4 gq = (*(const f32x4*)(modprev + b * 6144 + 5 * 1024 + c) + 1.0f) * (1.0f / FS_O);
#pragma unroll
                    for (int q = 0; q < 4; ++q) ggv[j][4 * h + q] = gq[q]; } }
        typedef typename std::conditional<XF32, f32x4, v4u>::type XRaw; constexpr int XP = XF32 ? 2 : 1;
        XRaw rx[RPI][2][XP], nx[RPI][2][XP]; v2u ro0[COMBINE ? RPI : 1][2], ro1[COMBINE ? RPI : 1][2], no0[COMBINE ? RPI : 1][2], no1[COMBINE ? RPI : 1][2];
#define NORM_LOAD(dx, d0, d1, mbase) do { _Pragma("unroll") for (int rr = 0; rr < RPI; ++rr) _Pragma("unroll") for (int j = 0; j < 2; ++j) { const size_t m_ = (size_t)((mbase) + rr); \
            if constexpr (XF32) { dx[rr][j][0] = __builtin_nontemporal_load((const XRaw*)((const float*)xin + m_ * D + 512 * j + 8 * lane)); dx[rr][j][XP - 1] = __builtin_nontemporal_load((const XRaw*)((const float*)xin + m_ * D + 512 * j + 8 * lane + 4)); } \
            else { if constexpr (FINAL) dx[rr][j][0] = __builtin_nontemporal_load((const XRaw*)((const bf16*)xin + m_ * D + 512 * j + 8 * lane)); else dx[rr][j][0] = *(const XRaw*)((const bf16*)xin + m_ * D + 512 * j + 8 * lane); } \
            if constexpr (COMBINE) { d0[rr][j] = __builtin_nontemporal_load((const v2u*)(O2 + (2 * m_) * D + 512 * j + 8 * lane)); d1[rr][j] = __builtin_nontemporal_load((const v2u*)(O2 + (2 * m_ + 1) * D + 512 * j + 8 * lane)); } } } while (0)
        NORM_LOAD(rx, ro0, ro1, blk * 128 + wave * 16);
        for (int it = 0; it < NIT; ++it) {
            const int m0 = blk * 128 + wave * 16 + RPI * it;
            if (it + 1 < NIT) NORM_LOAD(nx, no0, no1, m0 + RPI);
#pragma unroll
            for (int rr = 0; rr < RPI; ++rr) { const size_t m = (size_t)(m0 + rr); float h[2][8]; float ss = 0.f;
#pragma unroll
                for (int j = 0; j < 2; ++j) {
                    if constexpr (XF32) {
#pragma unroll
                        for (int q = 0; q < 4; ++q) { h[j][q] = rx[rr][j][0][q]; h[j][4 + q] = rx[rr][j][XP - 1][q]; } }
                    else unpack8(__builtin_bit_cast(v4u, rx[rr][j][0]), h[j]);
                    if constexpr (COMBINE) { float p0[8], p1[8]; unpack8_fp8(ro0[rr][j], p0); unpack8_fp8(ro1[rr][j], p1);
#pragma unroll
                        for (int q = 0; q < 8; ++q) h[j][q] += ggv[j][q] * (p0[q] + p1[q]);
                        if constexpr (!FINAL) *(v4u*)(xio + m * D + 512 * j + 8 * lane) = pack8(h[j]); }
#pragma unroll
                    for (int q = 0; q < 8; ++q) ss += h[j][q] * h[j][q]; }
                const float rstd = 1.0f / sqrtf(wave_sum(ss, lane) * (1.0f / D) + RMS_EPS);
#pragma unroll
                for (int j = 0; j < 2; ++j) {
#pragma unroll
                    for (int q = 0; q < 8; ++q) h[j][q] = h[j][q] * rstd * gmv[j][q] + shv[j][q];
                    if constexpr (FINAL) { __builtin_nontemporal_store((f32x4){h[j][0], h[j][1], h[j][2], h[j][3]}, (f32x4*)(outf + m * D + 512 * j + 8 * lane)); __builtin_nontemporal_store((f32x4){h[j][4], h[j][5], h[j][6], h[j][7]}, (f32x4*)(outf + m * D + 512 * j + 8 * lane + 4)); }
                    else *(v4u*)(XN + m * D + 512 * j + 8 * lane) = pack8(h[j]); } }
#pragma unroll
            for (int rr = 0; rr < RPI; ++rr)
#pragma unroll
                for (int j = 0; j < 2; ++j) {
#pragma unroll
                    for (int p = 0; p < XP; ++p) rx[rr][j][p] = nx[rr][j][p];
                    if constexpr (COMBINE) { ro0[rr][j] = no0[rr][j]; ro1[rr][j] = no1[rr][j]; } }
        }
#undef NORM_LOAD
    }
}

__device__ __forceinline__ void router_fold_row(const KArgs a, int row, int lane) {
    unsigned char* ws = a.ws();
    const int l = row / 96, b = (row / 48) & 1, n = row % 48;
    const bf16* wh = (const bf16*)(ws + WS_WR) + ((size_t)(l * 2) * 48 + n) * 1024 + lane * 16; const bf16* wl = wh + 48 * 1024;
    const float* gain = a.in(I_N2G) + l * 1024 + lane * 16; const float* md = (const float*)(ws + WS_MOD) + (size_t)(l * 2 + b) * 6144 + lane * 16;
    float acc = 0.f; unsigned o[8];
#pragma unroll
    for (int h = 0; h < 2; ++h) { float wv[8], lv[8]; unpack8(*(const v4u*)(wh + 8 * h), wv); unpack8(*(const v4u*)(wl + 8 * h), lv);
#pragma unroll
        for (int q = 0; q < 8; ++q) { const float w = wv[q] + lv[q]; acc += md[3 * 1024 + 8 * h + q] * w; wv[q] = w * gain[8 * h + q] * (1.0f + md[4 * 1024 + 8 * h + q]); }
#pragma unroll
        for (int q = 0; q < 4; ++q) o[4 * h + q] = pk2(wv[2 * q], wv[2 * q + 1]); }
    bf16* dst = (bf16*)(ws + WS_WRF) + ((size_t)(l * 2 + b) * 48 + n) * 1024 + lane * 16;
    *(v4u*)dst = (v4u){o[0], o[1], o[2], o[3]}; *(v4u*)(dst + 8) = (v4u){o[4], o[5], o[6], o[7]};
    acc = wave_sum(acc, lane);
    if (lane == 0) ((float*)(ws + WS_RBIAS))[row] = acc + (n < 4 ? a.in(I_BGB)[l * 4 + n] : (n < 36 ? a.in(I_BEB)[l * 32 + n - 4] : 0.f));
}

constexpr int LR_WH = 0, LR_WSTR = 1032, LR_GS = 99072, LR_RST = 107264, LR_LG = 107776;
__device__ __forceinline__ void router_phase(const KArgs a, LAS unsigned char* lds, int vcu, int G, int tid, int lane, int wave, const float* gain, const float* modl, int layer) {
    unsigned char* ws = a.ws();
    asm volatile("" : "+v"(tid)); lane = tid & 63;
    const bf16* XB = (const bf16*)(ws + WS_XB); unsigned char* XN = ws + WS_XN;
    LAS bf16* WH = (LAS bf16*)(lds + LR_WH); LAS float* GS = (LAS float*)(lds + LR_GS); LAS float* RST = (LAS float*)(lds + LR_RST) + wave * 16; LAS float* LG = (LAS float*)(lds + LR_LG) + wave * 768;
    LAS int* tokE = (LAS int*)(lds + L_TOK); LAS float* tokW = (LAS float*)(lds + L_TOK + 1024); LAS unsigned* lcnt = (LAS unsigned*)(lds + L_LCNT); LAS unsigned* lbase = lcnt + 32;
    for (int blk = vcu; blk < NTOK / 128; blk += G) {
        const int b = (blk * 128) >> 14;
        __syncthreads();
        { const bf16* WRF = (const bf16*)(ws + WS_WRF) + (size_t)(layer * 2 + b) * 48 * 1024;
#pragma unroll
          for (int i = 0; i < 12; ++i) { const int n = wave * 6 + (i >> 1), hf = i & 1;
              __builtin_amdgcn_global_load_lds((const unsigned*)(WRF + (size_t)n * 1024 + hf * 512 + lane * 8), (LAS unsigned*)(lds + LR_WH + n * (LR_WSTR * 2) + hf * 1024), 16, 0, 0); } }
        if (tid < 256) { const int c = 4 * tid; const f32x4 gn = *(const f32x4*)(gain + c), sc = *(const f32x4*)(modl + b * 6144 + 4 * 1024 + c); *(LAS f32x4*)(GS + c) = gn * (sc + 1.0f); }
        else { const int c = 4 * (tid - 256); *(LAS f32x4*)(GS + 1024 + c) = *(const f32x4*)(modl + b * 6144 + 3 * 1024 + c); }
        if (tid < 32) lcnt[tid] = 0u;
        LDS_WAIT(); __builtin_amdgcn_s_barrier();
        const int mw = blk * 128 + wave * 16;
        {
            float gmv[2][8], shv[2][8];
#pragma unroll
            for (int j = 0; j < 2; ++j)
#pragma unroll
                for (int h = 0; h < 2; ++h) { const f32x4 gq = *(const LAS f32x4*)(GS + 512 * j + 8 * lane + 4 * h), sq = *(const LAS f32x4*)(GS + 1024 + 512 * j + 8 * lane + 4 * h);
#pragma unroll
                    for (int q = 0; q < 4; ++q) { gmv[j][4 * h + q] = gq[q]; shv[j][4 * h + q] = sq[q]; } }
            v4u rx[4][2], nx[4][2];
#pragma unroll
            for (int rr = 0; rr < 4; ++rr)
#pragma unroll
                for (int j = 0; j < 2; ++j) rx[rr][j] = *(const v4u*)(XB + (size_t)(mw + rr) * D + 512 * j + 8 * lane);
            for (int it = 0; it < 4; ++it) {
                const int m0 = mw + 4 * it;
                if (it + 1 < 4) {
#pragma unroll
                    for (int rr = 0; rr < 4; ++rr)
#pragma unroll
                        for (int j = 0; j < 2; ++j) nx[rr][j] = *(const v4u*)(XB + (size_t)(m0 + 4 + rr) * D + 512 * j + 8 * lane); }
#pragma unroll
                for (int rr = 0; rr < 4; ++rr) { float h[2][8]; float ss = 0.f;
#pragma unroll
                    for (int j = 0; j < 2; ++j) { unpack8(rx[rr][j], h[j]);
#pragma unroll
                        for (int q = 0; q < 8; ++q) ss += h[j][q] * h[j][q]; }
                    const float rstd = 1.0f / sqrtf(wave_sum(ss, lane) * (1.0f / D) + RMS_EPS);
                    if (lane == 0) RST[4 * it + rr] = rstd;
#pragma unroll
                    for (int j = 0; j < 2; ++j) {
#pragma unroll
                        for (int q = 0; q < 8; ++q) h[j][q] = sat_fp8((h[j][q] * rstd * gmv[j][q] + shv[j][q]) * FS_XN);
                        v2u w8; w8.x = pk4_fp8(h[j][0], h[j][1], h[j][2], h[j][3]); w8.y = pk4_fp8(h[j][4], h[j][5], h[j][6], h[j][7]);
                        *(v2u*)(XN + (size_t)(m0 + rr) * D + 512 * j + 8 * lane) = w8; } }
#pragma unroll
                for (int rr = 0; rr < 4; ++rr)
#pragma unroll
                    for (int j = 0; j < 2; ++j) rx[rr][j] = nx[rr][j];
            }
        }
        LDS_WAIT(); asm volatile("" ::: "memory");
        asm volatile("s_waitcnt vmcnt(0)" ::: "memory"); __builtin_amdgcn_s_barrier();
        {
            const int fr = lane & 15, fq = lane >> 4;
            const bf16* xrow = XB + (size_t)(mw + fr) * D + fq * 8;
            f32x4 acc[3];
#pragma unroll
            for (int t = 0; t < 3; ++t) acc[t] = (f32x4){0.f, 0.f, 0.f, 0.f};
            {
                constexpr int kg = 0; v4u xq8[32];
#pragma unroll
                for (int u = 0; u < 32; ++u) xq8[u] = *(const v4u*)(xrow + (kg + u) * 32);
#pragma unroll
                for (int u = 0; u < 32; ++u) { const int k0 = (kg + u) * 32 + fq * 8; const bf16x8 ax = __builtin_bit_cast(bf16x8, xq8[u]);
#pragma unroll
                    for (int t = 0; t < 3; ++t) { const bf16x8 bh = *(const LAS bf16x8*)(WH + (t * 16 + fr) * LR_WSTR + k0);
                        acc[t] = __builtin_amdgcn_mfma_f32_16x16x32_bf16(ax, bh, acc[t], 0, 0, 0); } }
            }
            const float* rb = (const float*)(ws + WS_RBIAS) + (layer * 2 + b) * 48;
#pragma unroll
            for (int t = 0; t < 3; ++t) { const float bias = rb[t * 16 + fr];
#pragma unroll
                for (int r = 0; r < 4; ++r) LG[(4 * fq + r) * 48 + t * 16 + fr] = acc[t][r] * RST[4 * fq + r] + bias; }
        }
        LDS_WAIT(); asm volatile("" ::: "memory");
        if (lane < 16) {
            const LAS float* lg = LG + lane * 48;
            float gl[4]; int gi = 0;
#pragma unroll
            for (int j = 0; j < 4; ++j) gl[j] = lg[j];
            float gmax = gl[0];
#pragma unroll
            for (int j = 1; j < 4; ++j) if (gl[j] > gmax) { gmax = gl[j]; gi = j; }
            float gsum = 0.f;
#pragma unroll
            for (int j = 0; j < 4; ++j) gsum += expf(gl[j] - gmax);
            const float gp = 1.0f / gsum;
            float e0v = -3.0e38f, e1v = -3.0e38f; int e0 = 0, e1 = 0;
#pragma unroll
            for (int j = 0; j < 8; ++j) { const float v = lg[4 + gi * 8 + j];
                if (v > e0v) { e1v = e0v; e1 = e0; e0v = v; e0 = j; } else if (v > e1v) { e1v = v; e1 = j; } }
            const float dd = expf(e1v - e0v), w0 = gp / (1.0f + dd), w1 = gp * dd / (1.0f + dd);
            const int rl = wave * 16 + lane;
            tokE[rl * 2] = gi * 8 + e0; tokE[rl * 2 + 1] = gi * 8 + e1; tokW[rl * 2] = w0; tokW[rl * 2 + 1] = w1;
        }
        {
            unsigned* cntg = CTLP(ws) + CW_CNT + layer * 32; unsigned* listi = (unsigned*)(ws + WS_LISTI); float* listw = (float*)(ws + WS_LISTW);
            __syncthreads();
            int e = 0; unsigned rank = 0;
            if (tid < 256) { e = tokE[tid]; rank = atomicAdd((unsigned*)&lcnt[e], 1u); }
            __syncthreads();
            if (tid < 32) { const unsigned n = lcnt[tid]; lbase[tid] = n ? atomicAdd(&cntg[tid], n) : 0u; }
            __syncthreads();
            if (tid < 256) { const unsigned pos = lbase[e] + rank; const unsigned m = (unsigned)(blk * 128 + (tid >> 1));
                listi[(size_t)e * NTOK + pos] = m * 2u + (unsigned)(tid & 1); listw[(size_t)e * NTOK + pos] = tokW[tid]; }
        }
    }
}

__device__ __forceinline__ void scan_phase(const KArgs a, LAS unsigned char* lds, int task0, int task1, int tstep, int lane, int wave) {
    unsigned char* ws = a.ws();
    asm volatile("" : "+v"(lane));
    const bf16* SB = (const bf16*)(ws + WS_SB); bf16* UG = (bf16*)(ws + WS_UG); const float* SC = (const float*)(ws + WS_SC);
    LAS float* ex = (LAS float*)lds;
    for (int task = task0; task < task1; task += tstep) {
        const int b = task & 1, g = task >> 1, p = lane;
        const float ar = SC[(g * 64 + p) * 2], ai = SC[(g * 64 + p) * 2 + 1];
        const bf16* sp = SB + ((size_t)g * NCH + b * 512 + wave * 64) * 128 + p; bf16* up = UG + ((size_t)g * NCH + b * 512 + wave * 64) * UPITCH + 512 + p;
        float er = 0.f, ei = 0.f;
#pragma unroll 1
        for (int jb = 0; jb < 64; jb += 32) { float sr[32], si[32];
#pragma unroll
            for (int j = 0; j < 32; ++j) { sr[j] = __builtin_bit_cast(float, (unsigned)sp[(size_t)(jb + j) * 128] << 16); si[j] = __builtin_bit_cast(float, (unsigned)sp[(size_t)(jb + j) * 128 + 64] << 16); }
#pragma unroll
            for (int j = 0; j < 32; ++j) { const float nr = ar * er - ai * ei + sr[j], ni = ar * ei + ai * er + si[j]; er = nr; ei = ni; } }
        ex[(wave * 2) * 64 + p] = er; ex[(wave * 2 + 1) * 64 + p] = ei;
        float a64r = ar, a64i = ai;
#pragma unroll
        for (int s = 0; s < 6; ++s) { const float nr = a64r * a64r - a64i * a64i, ni = 2.0f * a64r * a64i; a64r = nr; a64i = ni; }
        __syncthreads();
        float hr = 0.f, hi = 0.f;
        for (int w = 0; w < wave; ++w) { const float qr = ex[(w * 2) * 64 + p], qi = ex[(w * 2 + 1) * 64 + p]; const float nr = a64r * hr - a64i * hi + qr, ni = a64r * hi + a64i * hr + qi; hr = nr; hi = ni; }
#pragma unroll 1
        for (int jb = 0; jb < 64; jb += 32) { float sr[32], si[32];
#pragma unroll
            for (int j = 0; j < 32; ++j) { sr[j] = __builtin_bit_cast(float, (unsigned)sp[(size_t)(jb + j) * 128] << 16); si[j] = __builtin_bit_cast(float, (unsigned)sp[(size_t)(jb + j) * 128 + 64] << 16); }
#pragma unroll
            for (int j = 0; j < 32; ++j) { up[(size_t)(jb + j) * UPITCH] = (bf16)f2bf(hr); up[(size_t)(jb + j) * UPITCH + 64] = (bf16)f2bf(hi);
                const float nr = ar * hr - ai * hi + sr[j], ni = ar * hi + ai * hr + si[j]; hr = nr; hi = ni; } }
        __syncthreads();
    }
}

__device__ __forceinline__ void conv_phase(const KArgs a, int vcu, int G, int tid) {
    unsigned char* ws = a.ws();
    const bf16* BG = (const bf16*)(ws + WS_BG); const bf16* UU = (const bf16*)(ws + WS_UU); unsigned char* A3 = ws + WS_A3;
    asm volatile("" : "+v"(tid));
    const int cg = tid & 127, rq = tid >> 7; const float* cw = a.in(I_CW);
    float w0[8], w1[8], w2[8];
#pragma unroll
    for (int j = 0; j < 8; ++j) { w0[j] = cw[cg * 8 + j]; w1[j] = cw[1024 + cg * 8 + j]; w2[j] = cw[2048 + cg * 8 + j]; }
    for (int blk = vcu; blk < NTOK / 128; blk += G) {
        const int m0 = blk * 128 + rq * 32; const int t0 = m0 & (SEQ - 1);
        float u1[8], u2[8];
#pragma unroll
        for (int j = 0; j < 8; ++j) { u1[j] = 0.f; u2[j] = 0.f; }
        if (t0 >= 1) { const v4u q = *(const v4u*)(UU + (size_t)(m0 - 1) * D + cg * 8); u1[0] = bf_lo(q.x); u1[1] = bf_hi(q.x); u1[2] = bf_lo(q.y); u1[3] = bf_hi(q.y); u1[4] = bf_lo(q.z); u1[5] = bf_hi(q.z); u1[6] = bf_lo(q.w); u1[7] = bf_hi(q.w); }
        if (t0 >= 2) { const v4u q = *(const v4u*)(UU + (size_t)(m0 - 2) * D + cg * 8); u2[0] = bf_lo(q.x); u2[1] = bf_hi(q.x); u2[2] = bf_lo(q.y); u2[3] = bf_hi(q.y); u2[4] = bf_lo(q.z); u2[5] = bf_hi(q.z); u2[6] = bf_lo(q.w); u2[7] = bf_hi(q.w); }
        v4u qq[8], bqq[8], nq[8], nbq[8];
#pragma unroll
        for (int r = 0; r < 8; ++r) { const size_t off = (size_t)(m0 + r) * D + cg * 8; qq[r] = __builtin_nontemporal_load((const v4u*)(UU + off)); bqq[r] = __builtin_nontemporal_load((const v4u*)(BG + off)); }
        for (int r0 = 0; r0 < 32; r0 += 8) {
            if (r0 + 8 < 32) {
#pragma unroll
                for (int r = 0; r < 8; ++r) { const size_t off = (size_t)(m0 + r0 + 8 + r) * D + cg * 8; nq[r] = __builtin_nontemporal_load((const v4u*)(UU + off)); nbq[r] = __builtin_nontemporal_load((const v4u*)(BG + off)); } }
#pragma unroll
            for (int r = 0; r < 8; ++r) { const size_t off = (size_t)(m0 + r0 + r) * D + cg * 8; const v4u q = qq[r], bq = bqq[r];
                float u0[8], bb[8], z[8];
                u0[0] = bf_lo(q.x); u0[1] = bf_hi(q.x); u0[2] = bf_lo(q.y); u0[3] = bf_hi(q.y); u0[4] = bf_lo(q.z); u0[5] = bf_hi(q.z); u0[6] = bf_lo(q.w); u0[7] = bf_hi(q.w);
                bb[0] = bf_lo(bq.x); bb[1] = bf_hi(bq.x); bb[2] = bf_lo(bq.y); bb[3] = bf_hi(bq.y); bb[4] = bf_lo(bq.z); bb[5] = bf_hi(bq.z); bb[6] = bf_lo(bq.w); bb[7] = bf_hi(bq.w);
#pragma unroll
                for (int j = 0; j < 8; ++j) { z[j] = bb[j] * (w0[j] * u2[j] + w1[j] * u1[j] + w2[j] * u0[j]); u2[j] = u1[j]; u1[j] = u0[j]; }
                v2u o; o.x = pk4_fp8(sat_fp8(z[0] * FS_A3), sat_fp8(z[1] * FS_A3), sat_fp8(z[2] * FS_A3), sat_fp8(z[3] * FS_A3)); o.y = pk4_fp8(sat_fp8(z[4] * FS_A3), sat_fp8(z[5] * FS_A3), sat_fp8(z[6] * FS_A3), sat_fp8(z[7] * FS_A3)); *(v2u*)(A3 + off) = o; }
#pragma unroll
            for (int r = 0; r < 8; ++r) { qq[r] = nq[r]; bqq[r] = nbq[r]; }
        }
    }
}

template <int MODE>
__device__ __forceinline__ int moe_setup(const KArgs a, LAS unsigned char* lds, int G, int bx, int tid, int layer) {
    unsigned char* ws = a.ws();
    const unsigned* cntg = CTLP(ws) + CW_CNT + layer * 32; const unsigned* listi = (const unsigned*)(ws + WS_LISTI); const unsigned* listw = (const unsigned*)(ws + WS_LISTW);
    asm volatile("" : "+v"(tid));
    LAS int* lc = (LAS int*)(lds + L_CNT); LAS int* tb = lc + 32; LAS int* nun = tb + 34;
    LAS gm::UnitRec* ut = (LAS gm::UnitRec*)(lds + L_UT); LAS unsigned* lists = (LAS unsigned*)(lds + L_LIST);
#if !MK_MULTI
    if (MODE == 1) return nun[0];
#endif
    if (tid < 64) {
        const int lane = tid, ex = lane & 31;
        const int c = (int)__hip_atomic_load(cntg + ex, __ATOMIC_RELAXED, __HIP_MEMORY_SCOPE_AGENT);
        const int tl = (c + 255) >> 8; int incl = tl;
#pragma unroll
        for (int o = 1; o < 32; o <<= 1) { const int t = shi(incl, lane - o, lane); if (ex >= o) incl += t; }
        const int excl = incl - tl, total = shi(incl, (lane & 32) + 31, lane);
        if (lane < 32) { lc[lane] = c; tb[lane] = excl; }
        const int U = total * 4; int start, end, stride, j;
        if ((G & 7) == 0) { const int x = bx & 7; start = 4 * ((x * total) / 8); end = 4 * (((x + 1) * total) / 8); stride = G >> 3; j = bx >> 3; } else { start = 0; end = U; stride = G; j = bx; }
        const int nxu = end - start, rounds = nxu / stride, rem = nxu - rounds * stride; const bool split = rem > 0 && 2 * rem <= stride;
        int uu = start + j + lane * stride, hm = 0; bool valid = lane < MAXU && lane < rounds;
        if (lane == rounds) { if (split) { uu = start + rounds * stride + (j >> 1); hm = 1 + (j & 1); valid = (j < 2 * rem) && lane < MAXU; } else valid = (j < rem) && lane < MAXU; }
        const int tg = uu >> 2, pn = uu & 3; int ee = 0;
#pragma unroll
        for (int k = 0; k < 31; ++k) ee += (shi(incl, (lane & 32) + k, lane) <= tg) ? 1 : 0;
        const int rt = tg - shi(excl, (lane & 32) + ee, lane);
        if (valid) { ut[lane].e = ee; ut[lane].rt = rt; ut[lane].tg = tg; ut[lane].pn = pn | (hm << 8); }
        const int n = __builtin_popcountll(__ballot(valid));
        if (lane == 0) { nun[0] = n; int L_, rk_; light_info(total, G, bx, L_, rk_); nun[1] = L_; nun[2] = rk_; }
    }
    __syncthreads();
    const int n = nun[0];
    for (int idx = tid; idx < n * 256; idx += 512) { const int ui = idx >> 8, r = idx & 255; const int e = ut[ui].e, pos = ut[ui].rt * 256 + r; const bool ok = pos < lc[e];
        lists[ui * 512 + r] = ok ? listi[(size_t)e * NTOK + pos] : 0xffffffffu; lists[ui * 512 + 256 + r] = ok ? listw[(size_t)e * NTOK + pos] : 0u; }
    __syncthreads();
    return n;
}

template <int LO, int HI>
__global__ void __launch_bounds__(NWAVES * 64, 2) fwd_kernel(Args args) {
    extern __shared__ __attribute__((aligned(16))) unsigned char lds_raw[];
    LAS unsigned char* lds = (LAS unsigned char*)lds_raw;
    const int wave = __builtin_amdgcn_readfirstlane((int)threadIdx.x >> 6); const int tid0_ = threadIdx.x;
    const int G = gridDim.x; int bx = blockIdx.x; int vcu = (G % 8 == 0) ? (bx % 8) * (G / 8) + bx / 8 : bx; int lok = 0;
    volatile LAS unsigned* MISC = (volatile LAS unsigned*)(lds + L_MISC);
    if (tid0_ < 32) MISC[tid0_] = 0u;
    __syncthreads();
    XcdBarrier bar; bar.bar = nullptr; bar.x = 0; bar.st = nullptr;
    if constexpr (HI - LO > 1) bar = xcd_barrier_post(CTLP(args.ws) + CW_BAR, MISC + 8, wave);
#define GRID_BAR() do { XcdBarrier b_ = bar; asm volatile("" : "+s"(b_.bar), "+s"(b_.x)); xcd_barrier<false>(b_, wave); } while (0)
#define XCD_BAR() do { XcdBarrier b_ = bar; asm volatile("" : "+s"(b_.bar), "+s"(b_.x)); xcd_barrier<true>(b_, wave); } while (0)
    constexpr int lo = LO, hi = HI;
#ifndef PHM
#define PHM 0x3ffff
#endif
#define EN(s) (((PHM) >> (s)) & 1)
#ifndef DBLM
#define DBLM 0
#endif
#define REP(s) for (int rep_ = 0; rep_ < 1 + (((DBLM) >> (s)) & 1); ++rep_)
#define IN(k) (lo <= (k) && (k) < hi)
#define SEAM(k) do { if (IN(k) && IN((k) + 1)) GRID_BAR(); } while (0)
#define SEAM_L(k) do { if (IN(k) && IN((k) + 1)) XCD_BAR(); } while (0)
#define PHASE_ARGS const int lane = fresh_lane(), tid = wave * 64 + lane; (void)tid; const KArgs a = fresh_args(); unsigned char* const ws = a.ws(); const float* const mod = (const float*)(ws + WS_MOD); (void)mod

    if (EN(0) && IN(0)) REP(0) { PHASE_ARGS; p0_prologue(a, lds, vcu, G, tid, lane, wave); } SEAM(0);
    if constexpr (HI - LO > 1) if (IN(0) && IN(1)) { lok = __builtin_amdgcn_readfirstlane((int)MISC[8 + 2]);
        if (lok) { const int rk_ = __builtin_amdgcn_readfirstlane((int)MISC[8 + 3]), x_ = (int)bar.x; vcu = x_ * 32 + rk_; bx = rk_ * 8 + x_; } }

    if (EN(1) && IN(1)) REP(1) { PHASE_ARGS; if (wave == 0) for (int row_ = vcu; row_ < 192; row_ += G) router_fold_row(a, row_, lane);
        norm_phase<false, false, true>(a, lds, vcu, G, tid, lane, wave, a.in(I_X), nullptr, nullptr, a.in(I_N1G), mod, 0, nullptr); } SEAM_L(1);
    if (EN(2) && IN(2)) REP(2) { PHASE_ARGS; gm::RegSched<0> S; S.init(ws + WS_XN, ws + WS_WIN, 1024, 1024, G, bx); gm::EpiInproj E{(bf16*)(ws + WS_UG)};
        gm::gemm_phase<gm::EpiInproj, gm::RegSched<0>, true>(lds, S, E, wave); } SEAM(2);
    if (EN(3) && IN(3)) REP(3) { PHASE_ARGS; gm::SsmSched<0> S; S.init(ws + WS_UG, ws + WS_BM, G, vcu); gm::EpiS1 E{(bf16*)(ws + WS_SB)};
        gm::gemm_phase<gm::EpiS1, gm::SsmSched<0>, true>(lds, S, E, wave); } SEAM_L(3);
    if (EN(4) && IN(4)) REP(4) { PHASE_ARGS;
        if (lok) { const int x_ = vcu >> 5, rk_ = vcu & 31;
            if (rk_ < 16) scan_phase(a, lds, 16 * x_ + rk_, 16 * x_ + rk_ + 1, 1, lane, wave);
            else deferred_items(a, lds, 0, DEF_A, (x_ * 16 + rk_ - 16) * NWAVES + wave, 128 * NWAVES, wave); }
        else { scan_phase(a, lds, vcu, 2 * NGRP, G, lane, wave);
            if (G == 256 && vcu >= 128) deferred_items(a, lds, 0, DEF_A, (vcu - 128) * NWAVES + wave, 128 * NWAVES, wave); } } SEAM_L(4);
    if (EN(5) && IN(5)) REP(5) { PHASE_ARGS; gm::SsmSched<1> S; S.init(ws + WS_UG, ws + WS_BT, G, vcu); S.B2s = (const char*)(ws + WS_CM); if (lok) { S.G = 32; S.vcu = (vcu >> 5) * 64 + (vcu & 31); S.lim = 2; } gm::EpiY E{(bf16*)(ws + WS_GG)};
        gm::gemm_phase<gm::EpiY, gm::SsmSched<1>, true>(lds, S, E, wave); } SEAM(5);
    if (EN(6) && IN(6)) REP(6) { PHASE_ARGS; gm::RegSched<1> S; S.init(ws + WS_GG, ws + WS_WGLU, 2048, 1024, G, bx); gm::EpiGlu E{a.in(I_X), (bf16*)(ws + WS_XB), mod + 2 * 1024};
        gm::gemm_phase<gm::EpiGlu, gm::RegSched<1>, true>(lds, S, E, wave); } SEAM_L(6);

    for (int l = 0; l < 2; ++l) {
        const int pb = 7 + 7 * l;
        int z0_ = 0; asm volatile("" : "+s"(z0_)); LAS unsigned char* const lds_l = lds + z0_;
        if (l == 1) {
            if (EN(10) && IN(10)) REP(10) { PHASE_ARGS;
                {
                    LAS int* nun_ = (LAS int*)(lds_l + L_CNT) + 66;
                    if (tid == 0) { const unsigned* cntg = CTLP(ws) + CW_CNT; int tot = 0; for (int e_ = 0; e_ < 32; ++e_) tot += (int)((__hip_atomic_load(cntg + e_, __ATOMIC_RELAXED, __HIP_MEMORY_SCOPE_AGENT) + 255u) >> 8);
                        int L_, rk_; light_info(tot, G, bx, L_, rk_); nun_[1] = L_; }
                    __syncthreads();
                    const int done_ = ((G == 256) ? DEF_A : 0) + nun_[1] * (DEF_QB + DEF_QC);
                    deferred_items(a, lds_l, done_, MOE_WITEMS - done_, vcu * NWAVES + wave, G * NWAVES, wave);
                    __syncthreads();
                }
                norm_phase<true, false, false>(a, lds_l, vcu, G, tid, lane, wave, ws + WS_XB, (bf16*)(ws + WS_XB), nullptr, a.in(I_N1G) + 1024, mod + 2 * 6144, 0, mod); } SEAM_L(10);
            if (EN(11) && IN(11)) REP(11) {
                { PHASE_ARGS; gm::RegSched<0> S; S.init(ws + WS_XN, ws + WS_WCIN, 2048, 1024, G, bx); gm::EpiCV E{(bf16*)(ws + WS_UU)};
                  gm::gemm_phase<gm::EpiCV, gm::RegSched<0>, true>(lds_l, S, E, wave); }
                { PHASE_ARGS; gm::RegSched<0> S; S.init(ws + WS_XN, ws + WS_WCIN + (size_t)2048 * 1024 * 2, 1024, 1024, G, bx); gm::EpiBf16 E{(bf16*)(ws + WS_BG), 1024};
                  gm::gemm_phase<gm::EpiBf16, gm::RegSched<0>, true>(lds_l, S, E, wave); }
            } SEAM(11);
            if (EN(12) && IN(12)) REP(12) { PHASE_ARGS; conv_phase(a, vcu, G, tid); } SEAM_L(12);
            if (EN(13) && IN(13)) REP(13) { PHASE_ARGS; gm::RegSched<0, true> S; S.init(ws + WS_A3, ws + WS_WCOUT, 1024, 1024, G, bx); gm::EpiResid E{(bf16*)(ws + WS_XB), mod + 2 * 6144 + 2 * 1024};
                gm::gemm_phase<gm::EpiResid, gm::RegSched<0, true>, true>(lds_l, S, E, wave); } SEAM_L(13);
        }
        if (EN(7) && IN(pb)) REP(7) { PHASE_ARGS; router_phase(a, lds_l, vcu, G, tid, lane, wave, a.in(I_N2G) + l * 1024, mod + l * 2 * 6144, l); } SEAM(pb);
        if (EN(8) && IN(pb + 1)) REP(8) { PHASE_ARGS; const int n = moe_setup<0>(a, lds_l, G, bx, tid, l);
            gm::MoeSched<0> S; S.init(ws + WS_XN, ws + WS_W13 + (size_t)l * 32 * 4 * 256 * 2048, (const LAS gm::UnitRec*)(lds_l + L_UT), (const LAS unsigned*)(lds_l + L_LIST), n);
            gm::EpiMoe1 E{ws + WS_HB};
            gm::gemm_phase<gm::EpiMoe1, gm::MoeSched<0>, true>(lds_l, S, E, wave);
            if (l == 0) { LAS int* nun_ = (LAS int*)(lds_l + L_CNT) + 66; const int rk_ = nun_[2]; const int doneA = (G == 256) ? DEF_A : 0;
                if (rk_ >= 0) deferred_items(a, lds_l, doneA + rk_ * DEF_QB, DEF_QB, wave, NWAVES, wave); } } SEAM_L(pb + 1);
        if (EN(9) && IN(pb + 2)) REP(9) { PHASE_ARGS; const int n = moe_setup<1>(a, lds_l, G, bx, tid, l);
            gm::MoeSched<1> S; S.init(ws + WS_HB, ws + WS_W2 + (size_t)l * 32 * 1024 * 1024, (const LAS gm::UnitRec*)(lds_l + L_UT), (const LAS unsigned*)(lds_l + L_LIST), n);
            gm::EpiMoe2 E{ws + WS_O2, (const LAS unsigned*)(lds_l + L_LIST)};
            gm::gemm_phase<gm::EpiMoe2, gm::MoeSched<1>, true>(lds_l, S, E, wave);
            if (l == 0) { LAS int* nun_ = (LAS int*)(lds_l + L_CNT) + 66; const int L_ = nun_[1], rk_ = nun_[2]; const int doneA = (G == 256) ? DEF_A : 0;
                if (rk_ >= 0) deferred_items(a, lds_l, doneA + L_ * DEF_QB + rk_ * DEF_QC, DEF_QC, wave, NWAVES, wave); } } SEAM(pb + 2);
    }
    if (EN(17) && IN(17)) REP(17) { PHASE_ARGS; norm_phase<true, true, false>(a, lds, vcu, G, tid, lane, wave, ws + WS_XB, nullptr, a.out(), a.in(I_FG), nullptr, 0, mod + 2 * 6144); }
#if !MK_MULTI
    if constexpr (HI - LO > 1) {
        const int lane = fresh_lane();
        asm volatile("s_waitcnt vmcnt(0)" ::: "memory"); __syncthreads();
        if (wave == 0 && lane == 0) MISC[0] = (xb_add(&g_ctl[0], 1u) == (unsigned)G - 1u) ? 1u : 0u;
        __syncthreads();
        if (MISC[0]) { const int tid = wave * 64 + lane;
            for (int i = tid; i < XCD_BAR_WORDS; i += NWAVES * 64) g_ctl[CW_BAR + i] = 0u;
            if (tid < 128) g_ctl[CW_CNT + tid] = 0u;
            if (tid == 0) g_ctl[0] = 0u; }
    }
#endif
#undef IN
#undef SEAM
}

extern "C" void kernel_launch(void* const* d_in, const int* in_sizes, int n_in, void* d_out, int out_size, void* d_ws, size_t ws_size, hipStream_t stream) {
    static int grid = 0;
    if (grid == 0) {
        if (n_in != 27 || in_sizes[0] != NTOK * D || out_size != NTOK * D || ws_size < WS_END) {
            fprintf(stderr, "kernel_launch: unexpected shapes (n_in %d, in0 %d, out %d, ws %zu < %zu); nothing launched\n", n_in, n_in > 0 ? in_sizes[0] : -1, out_size, ws_size, (size_t)WS_END); grid = -1; return; }
        int dev = 0, cus = 0, per_cu = 0;
        if (hipGetDevice(&dev) != hipSuccess || hipDeviceGetAttribute(&cus, hipDeviceAttributeMultiprocessorCount, dev) != hipSuccess) { grid = -1; return; }
#if MK_MULTI
#define SET_ATTR(p) ok = ok && (hipFuncSetAttribute((const void*)fwd_kernel<p, p + 1>, hipFuncAttributeMaxDynamicSharedMemorySize, LDS_BYTES) == hipSuccess)
        bool ok = true; SET_ATTR(0); SET_ATTR(1); SET_ATTR(2); SET_ATTR(3); SET_ATTR(4); SET_ATTR(5); SET_ATTR(6); SET_ATTR(7); SET_ATTR(8); SET_ATTR(9);
        SET_ATTR(10); SET_ATTR(11); SET_ATTR(12); SET_ATTR(13); SET_ATTR(14); SET_ATTR(15); SET_ATTR(16); SET_ATTR(17);
        if (!ok) { fprintf(stderr, "kernel_launch: hipFuncSetAttribute failed\n"); grid = -1; return; }
        per_cu = 1;
#else
        if (hipFuncSetAttribute((const void*)fwd_kernel<0, NPH>, hipFuncAttributeMaxDynamicSharedMemorySize, LDS_BYTES) != hipSuccess) { fprintf(stderr, "kernel_launch: hipFuncSetAttribute failed\n"); grid = -1; return; }
        if (hipOccupancyMaxActiveBlocksPerMultiprocessor(&per_cu, (const void*)fwd_kernel<0, NPH>, NWAVES * 64, LDS_BYTES) != hipSuccess || per_cu < 1)
            fprintf(stderr, "kernel_launch: note: occupancy query reports %d workgroups per CU\n", per_cu);
#endif
        (void)hipGetLastError();
        grid = cus;
    }
    if (grid < 0) return;
#if MK_MULTI
    if (hipMemsetAsync((char*)d_ws + WS_CTL, 0, CTL_ZERO_BYTES, stream) != hipSuccess) return;
#endif
    Args a{};
    for (int i = 0; i < 27; ++i) a.in[i] = (const float*)d_in[i];
    a.out = (float*)d_out; a.ws = (unsigned char*)d_ws;
#if MK_MULTI
#define LAUNCH_PH(p) do { a.ph_lo = p; a.ph_hi = p + 1; hipLaunchKernelGGL((fwd_kernel<p, p + 1>), dim3(grid), dim3(NWAVES * 64), LDS_BYTES, stream, a); } while (0)
    LAUNCH_PH(0); LAUNCH_PH(1); LAUNCH_PH(2); LAUNCH_PH(3); LAUNCH_PH(4); LAUNCH_PH(5); LAUNCH_PH(6); LAUNCH_PH(7); LAUNCH_PH(8); LAUNCH_PH(9);
    LAUNCH_PH(10); LAUNCH_PH(11); LAUNCH_PH(12); LAUNCH_PH(13); LAUNCH_PH(14); LAUNCH_PH(15); LAUNCH_PH(16); LAUNCH_PH(17);
#else
    a.ph_lo = 0; a.ph_hi = NPH;
    hipLaunchKernelGGL((fwd_kernel<0, NPH>), dim3(grid), dim3(NWAVES * 64), LDS_BYTES, stream, a);
#endif
}
```

```cpp
#include <hip/hip_runtime.h>
#include <cstdio>
#include <cstdint>
#include <type_traits>

#ifndef MK_MULTI
#define MK_MULTI 0
#endif

#define GAS __attribute__((address_space(1)))
#define LAS __attribute__((address_space(3)))
typedef unsigned short bf16;
typedef unsigned v4u __attribute__((ext_vector_type(4)));
typedef unsigned v2u __attribute__((ext_vector_type(2)));
typedef float f32x4 __attribute__((ext_vector_type(4)));
typedef float f32x2 __attribute__((ext_vector_type(2)));
typedef short bf16x8 __attribute__((ext_vector_type(8)));

constexpr int NTOK = 32768, D = 1024, SEQ = 16384;
constexpr int NGRP = 64, NST = 64, GCH = 16, LC = 32;
constexpr int NCH = NTOK / LC;
constexpr int UPITCH = 640;
constexpr int NEXP = 32, DEXP = 512;
constexpr float RMS_EPS = 1e-6f;
constexpr int NWAVES = 8;

constexpr size_t MiB = 1u << 20;
constexpr size_t WS_CTL = 0, CTL_ZERO_BYTES = 128 * 1024;
constexpr size_t WS_RBIAS = 192 * 1024;
constexpr size_t WS_WRF = 256 * 1024;
constexpr size_t WS_MOD = 1 * MiB;
constexpr size_t WS_SC = 1 * MiB + 512 * 1024;
constexpr size_t WS_WR = 1 * MiB + 640 * 1024;
constexpr size_t WS_WIN = 2 * MiB, WS_WGLU = 4 * MiB, WS_WCIN = 8 * MiB, WS_WCOUT = 14 * MiB;
constexpr size_t WS_BM = 16 * MiB;
constexpr size_t WS_LISTI = 16 * MiB, WS_LISTW = 20 * MiB;
constexpr size_t WS_BT = 24 * MiB;
constexpr size_t WS_ROWMAP = 34 * MiB;
constexpr size_t WS_CM = 26 * MiB;
constexpr size_t WS_W13 = 64 * MiB;
constexpr size_t WS_W2 = 192 * MiB;
constexpr size_t WS_XN = 256 * MiB;
constexpr size_t WS_SCR = 320 * MiB;
constexpr size_t WS_XB = WS_SCR;
constexpr size_t WS_UG = WS_SCR, WS_SB = WS_SCR + 80 * MiB, WS_GG = WS_SCR + 112 * MiB;
constexpr size_t WS_BG = WS_SCR + 64 * MiB, WS_UU = WS_W13, WS_A3 = WS_SCR + 192 * MiB;
constexpr size_t WS_HB = WS_SCR + 64 * MiB, WS_O2 = WS_SCR + 136 * MiB;
constexpr size_t WS_END = 584 * MiB;
constexpr int CW_BAR = 4096;
constexpr int CW_CNT = 16384;

constexpr int L_STAGE = 0;
constexpr int L_LIST = 133120;
constexpr int L_UT = 145408;
constexpr int L_CNT = 145664;
constexpr int L_RED = 149504;
constexpr int L_TOK = 151808;
constexpr int L_LCNT = 153856;
constexpr int L_MISC = 155520;
constexpr int LDS_BYTES = 155648;
constexpr int MAXU = 6;

#define LDS_WAIT() asm volatile("s_waitcnt lgkmcnt(0)" ::: "memory")
#define VM_WAIT() asm volatile("s_waitcnt vmcnt(0)" ::: "memory")
__device__ __forceinline__ unsigned f2bf(float f) { unsigned u = __builtin_bit_cast(unsigned, f); return (u + 0x7fffu + ((u >> 16) & 1u)) >> 16; }
typedef __bf16 bf16x2_t __attribute__((ext_vector_type(2)));
__device__ __forceinline__ unsigned pk2(float lo, float hi) { const f32x2 v = {lo, hi}; return __builtin_bit_cast(unsigned, __builtin_convertvector(v, bf16x2_t)); }
__device__ __forceinline__ float bf_lo(unsigned w) { return __builtin_bit_cast(float, w << 16); }
__device__ __forceinline__ float bf_hi(unsigned w) { return __builtin_bit_cast(float, w & 0xffff0000u); }
constexpr float FS_XN = 16.f, FS_W13 = 64.f, FS_H = 8.f, FS_W2 = 64.f, FS_O = 16.f, FS_A3 = 8.f, FS_WCO = 64.f, FS_WCI = 64.f;
typedef short v2s_ __attribute__((ext_vector_type(2)));
__device__ __forceinline__ unsigned pk4_fp8(float a, float b, float c, float d) { v2s_ r = {0, 0}; r = __builtin_amdgcn_cvt_scalef32_pk_fp8_f32(r, a, b, 1.0f, false); r = __builtin_amdgcn_cvt_scalef32_pk_fp8_f32(r, c, d, 1.0f, true);
    return (unsigned)(unsigned short)r.x | ((unsigned)(unsigned short)r.y << 16); }
__device__ __forceinline__ void unpack8_fp8(v2u q, float (&f)[8]) {
    typedef float f32x2_ __attribute__((ext_vector_type(2)));
    const f32x2_ a = __builtin_amdgcn_cvt_pk_f32_fp8((int)q.x, false), b = __builtin_amdgcn_cvt_pk_f32_fp8((int)q.x, true), c = __builtin_amdgcn_cvt_pk_f32_fp8((int)q.y, false), d = __builtin_amdgcn_cvt_pk_f32_fp8((int)q.y, true);
    f[0] = a[0]; f[1] = a[1]; f[2] = b[0]; f[3] = b[1]; f[4] = c[0]; f[5] = c[1]; f[6] = d[0]; f[7] = d[1]; }
__device__ __forceinline__ unsigned pk4_fp8_div(float a, float b, float c, float d, float pow2) { v2s_ r = {0, 0}; r = __builtin_amdgcn_cvt_scalef32_pk_fp8_f32(r, a, b, pow2, false); r = __builtin_amdgcn_cvt_scalef32_pk_fp8_f32(r, c, d, pow2, true);
    return (unsigned)(unsigned short)r.x | ((unsigned)(unsigned short)r.y << 16); }
__device__ __forceinline__ float sat_fp8(float x) { return x; }
__device__ __forceinline__ unsigned cvt_pk_bf16(float lo, float hi) { unsigned r; asm volatile("v_cvt_pk_bf16_f32 %0, %1, %2" : "=v"(r) : "v"(lo), "v"(hi)); return r; }
__device__ __forceinline__ float shx(float v, int mask, int lane) { return __builtin_bit_cast(float, __builtin_amdgcn_ds_bpermute((lane ^ mask) << 2, __builtin_bit_cast(int, v))); }
__device__ __forceinline__ int shi(int v, int src, int lane) { (void)lane; return __builtin_amdgcn_ds_bpermute(src << 2, v); }
__device__ __forceinline__ float dpp_add(float v, int ctrl_sel) {
    const int vi = __builtin_bit_cast(int, v); int r;
    if (ctrl_sel == 0) r = __builtin_amdgcn_update_dpp(0, vi, 0xB1, 0xf, 0xf, true);
    else if (ctrl_sel == 1) r = __builtin_amdgcn_update_dpp(0, vi, 0x4E, 0xf, 0xf, true);
    else if (ctrl_sel == 2) r = __builtin_amdgcn_update_dpp(0, vi, 0x141, 0xf, 0xf, true);
    else r = __builtin_amdgcn_update_dpp(0, vi, 0x140, 0xf, 0xf, true);
    return v + __builtin_bit_cast(float, r);
}
__device__ __forceinline__ float wave_sum(float v, int lane) {
    v = dpp_add(v, 0); v = dpp_add(v, 1); v = dpp_add(v, 2); v = dpp_add(v, 3);
    v += shx(v, 16, lane); v += shx(v, 32, lane);
    return v;
}
__device__ __forceinline__ float sigmoidf_(float x) { return __builtin_amdgcn_rcpf(1.0f + __builtin_amdgcn_exp2f(-1.4426950408889634f * x)); }
__device__ __forceinline__ f32x2 pk_mul(f32x2 a, f32x2 b) { f32x2 r; asm("s_nop 0\n\tv_pk_mul_f32 %0, %1, %2" : "=v"(r) : "v"(a), "v"(b)); return r; }
__device__ __forceinline__ f32x2 pk_add(f32x2 a, f32x2 b) { f32x2 r; asm("s_nop 0\n\tv_pk_add_f32 %0, %1, %2" : "=v"(r) : "v"(a), "v"(b)); return r; }
__device__ __forceinline__ f32x2 pk_fma(f32x2 a, f32x2 b, f32x2 c) { f32x2 r; asm("s_nop 0\n\tv_pk_fma_f32 %0, %1, %2, %3" : "=v"(r) : "v"(a), "v"(b), "v"(c)); return r; }
__device__ __forceinline__ f32x2 exp2_2(f32x2 t) { return (f32x2){__builtin_amdgcn_exp2f(t[0]), __builtin_amdgcn_exp2f(t[1])}; }
__device__ __forceinline__ f32x2 rcp_2(f32x2 t) { return (f32x2){__builtin_amdgcn_rcpf(t[0]), __builtin_amdgcn_rcpf(t[1])}; }
__device__ __forceinline__ f32x2 gelu_tanh2(f32x2 x, f32x2 kc2, f32x2 kc1, f32x2 kone) {
    const f32x2 u = pk_mul(x, pk_fma(pk_mul(x, x), kc2, kc1)); return pk_mul(x, rcp_2(pk_add(exp2_2(u), kone))); }
__device__ __forceinline__ float gelu_tanh(float x) { const float x2 = x * x, u = x * (-2.3022082f - 0.10294324f * x2); return x * __builtin_amdgcn_rcpf(1.0f + __builtin_amdgcn_exp2f(u)); }

__device__ __forceinline__ int fresh_lane() { unsigned m_ = ~0u; asm volatile("" : "+s"(m_)); return (int)__builtin_amdgcn_mbcnt_hi(m_, __builtin_amdgcn_mbcnt_lo(m_, 0u)); }
#define XB_TMO      128
#define XB_XCNT(j)  (256  + 64 * (j))
#define XB_XSUB(j)  (1280 + 64 * (j))
#define XB_XGEN(j)  (2304 + 64 * (j))
#define XB_TOP      3328
#define XB_TOPGEN   3392
#define XCD_BAR_WORDS 3456
#define XB_SPIN_CAP (1u << 18)
__device__ __forceinline__ unsigned xb_ld(unsigned* p)              { return __hip_atomic_load(p, __ATOMIC_RELAXED, __HIP_MEMORY_SCOPE_AGENT); }
__device__ __forceinline__ unsigned xb_add(unsigned* p, unsigned v) { return __hip_atomic_fetch_add(p, v, __ATOMIC_RELAXED, __HIP_MEMORY_SCOPE_AGENT); }
__device__ __forceinline__ unsigned xb_xcc_id() { return (unsigned)__builtin_amdgcn_s_getreg((3 << 11) | 20) & 0xFu; }
#define XB_SPIN(cond, bar) do { unsigned _sp = 0; while (cond) { __builtin_amdgcn_s_sleep(1); \
    if ((++_sp & 255u) == 0u) { if (xb_ld(&(bar)[XB_TMO])) break; if (_sp > XB_SPIN_CAP) { atomicAdd(&(bar)[XB_TMO], 1u); break; } } } } while (0)
struct XcdBarrier { unsigned* bar; unsigned x; volatile LAS unsigned* st; };
__device__ __forceinline__ XcdBarrier xcd_barrier_post(unsigned* bar, volatile LAS unsigned* st, int wave) {
    XcdBarrier b; b.bar = bar; b.x = xb_xcc_id(); b.st = st;
    if (wave == 0 && fresh_lane() == 0) st[3] = xb_add(&bar[XB_XCNT(b.x)], 1u);
    return b;
}
__device__ __forceinline__ void xcd_barrier_complete(unsigned* bar, unsigned x, unsigned& nloc, unsigned& nx, unsigned& full) {
    const unsigned G = gridDim.x * gridDim.y * gridDim.z;
    unsigned sum, cnt, mine, sp = 0u;
    for (;;) {
        sum = 0u; cnt = 0u; mine = 0u; full = 0u;
#pragma unroll
        for (unsigned j = 0; j < 16; ++j) { const unsigned c = xb_ld(&bar[XB_XCNT(j)]); sum += c; cnt += (c > 0u) ? 1u : 0u; mine = (j == x) ? c : mine; full += (j < 8u && c == 32u) ? 1u : 0u; }
        if (sum == G) break;
        __builtin_amdgcn_s_sleep(1);
        if ((++sp & 255u) == 0u) { if (xb_ld(&bar[XB_TMO])) break; if (sp > XB_SPIN_CAP) { atomicAdd(&bar[XB_TMO], 1u); break; } }
    }
    nloc = mine > 0u ? mine : 1u; nx = cnt > 0u ? cnt : 1u;
}
template <bool LOCAL = false>
__device__ __forceinline__ void xcd_barrier(const XcdBarrier& b, int wave) {
    asm volatile("s_waitcnt vmcnt(0)" ::: "memory");
    __syncthreads();
    if (wave == 0 && fresh_lane() == 0) {
        unsigned* bar = b.bar;
        __builtin_amdgcn_s_waitcnt(0);
        unsigned nloc = b.st[0], nx = b.st[1];
        if (nloc == 0u) { unsigned full; xcd_barrier_complete(bar, b.x, nloc, nx, full); b.st[0] = nloc; b.st[1] = nx; b.st[2] = (full == 8u && nx == 8u && gridDim.x == 256u) ? 1u : 0u; }
        const unsigned old = xb_add(&bar[XB_XSUB(b.x)], 1u);
        const unsigned gen = old / nloc;
        if (old + 1u == (gen + 1u) * nloc) {
            if (!(LOCAL && b.st[2] != 0u)) {
                __builtin_amdgcn_fence(__ATOMIC_RELEASE, "agent");
                asm volatile("s_waitcnt vmcnt(0)" ::: "memory");
                const unsigned og = xb_add(&bar[XB_TOP], 1u);
                const unsigned tg = og / nx;
                if (og + 1u == (tg + 1u) * nx) xb_add(&bar[XB_TOPGEN], 1u);
                else XB_SPIN(xb_ld(&bar[XB_TOPGEN]) == tg, bar);
            }
            __builtin_amdgcn_fence(__ATOMIC_ACQUIRE, "agent");
            xb_add(&bar[XB_XGEN(b.x)], 1u);
            asm volatile("s_waitcnt vmcnt(0)" ::: "memory");
        } else {
            XB_SPIN(xb_ld(&bar[XB_XGEN(b.x)]) == gen, bar);
            __builtin_amdgcn_fence(__ATOMIC_ACQUIRE, "agent");
            asm volatile("s_waitcnt vmcnt(0)" ::: "memory");
        }
    }
    __syncthreads();
}

struct Args { const float* in[27]; float* out; unsigned char* ws; int ph_lo, ph_hi; };
#define CAS __attribute__((address_space(4)))
struct KArgs {
    const CAS char* kp;
    __device__ __forceinline__ const float* in(int k) const { return *(const float* const CAS*)(kp + 8 * k); }
    __device__ __forceinline__ float* out() const { return *(float* const CAS*)(kp + 8 * 27); }
    __device__ __forceinline__ unsigned char* ws() const { return *(unsigned char* const CAS*)(kp + 8 * 28); }
};
__device__ __forceinline__ KArgs fresh_args() { KArgs k; k.kp = (const CAS char*)__builtin_amdgcn_kernarg_segment_ptr(); asm volatile("" : "+s"(k.kp)); return k; }

namespace gm {
constexpr int BM = 256, BK = 64, HALF = 128, HTB = HALF * BK * 2, STAGE_BYTES = 8 * HTB, NXCD = 8, WGM = 8;
__host__ __device__ __forceinline__ int lds_byte(int r, int c) { const int st = (r >> 4) * 2 + (c >> 5), rr = r & 15, cc = c & 31, ob = rr * 64 + cc * 2; return st * 1024 + (ob ^ (((ob >> 9) & 1) << 5)); }
__host__ __device__ __forceinline__ void stage_rc(int b, int& R, int& C) { const int st = b / 1024, sb = b % 1024, swz = sb ^ (((sb >> 9) & 1) << 5); R = (st >> 1) * 16 + swz / 64; C = (st & 1) * 32 + (swz % 64) / 2; }
__host__ __device__ __forceinline__ int perm32(int rho) { const int n = rho >> 4, i = rho & 15; return 8 * (i >> 2) + 4 * n + (i & 3); }

struct Unit { const char* A; const char* B; const char* B2; int p0, p1, p2, p3; int nt, kjump; int hm; };

typedef int v8i __attribute__((ext_vector_type(8)));
typedef int v4i_ __attribute__((ext_vector_type(4)));
__device__ __forceinline__ v8i cat8(bf16x8 lo, bf16x8 hi) { const v4i_ a = __builtin_bit_cast(v4i_, lo), b = __builtin_bit_cast(v4i_, hi); return __builtin_shufflevector(a, b, 0, 1, 2, 3, 4, 5, 6, 7); }
template <class Epi, class Sched, bool ALIGN_EPI>
__device__ __forceinline__ void gemm_phase(LAS unsigned char* lds, const Sched& S, const Epi& E, int wave_) {
    int tid_ = wave_ * 64 + fresh_lane(); asm volatile("" : "+v"(tid_));
    const int tid = tid_, wid = __builtin_amdgcn_readfirstlane(tid >> 6), lane = tid & 63, wr = wid >> 2, wc = wid & 3, fr = lane & 15, fq = lane >> 4;
    int nt = S.nt; int kjump = 0;
    const long kstepA = S.kstepA, kstepB = S.kstepB, hstepA = S.hstepA, hstepB = Epi::PERM2 ? S.hstepB / 16 : S.hstepB;
    unsigned voffA[2], voffB[2], voffB2[2] = {0u, 0u}; long hstepB2 = 0; if constexpr (Sched::BSPLIT) hstepB2 = S.hstepB2;
#pragma unroll
    for (int i = 0; i < 2; ++i) { int R, C; stage_rc(tid * 16 + i * 8192, R, C); const int Rb = Epi::PERM2 ? (64 * (R >> 5) + 16 * ((R >> 2) & 3) + 4 * ((R >> 4) & 1) + (R & 3)) : Epi::PERM ? ((R & ~31) + perm32(R & 31)) : R;
        voffA[i] = S.voffA(R, C); voffB[i] = S.voffB(Rb, C); if constexpr (Sched::BSPLIT) voffB2[i] = S.voffB2(Rb, C); }
    unsigned goff[2][2] = {{0u, 0u}, {0u, 0u}};
    const unsigned ldsw = (unsigned)wid * 1024u;
    const int aoff = lds_byte(wr * 64 + fr, fq * 8), boff = lds_byte(wc * 32 + fr, fq * 8);
#define G_SA(b, h) (((b) * 2 + (h)) * HTB)
#define G_SB(b, h) ((4 + (b) * 2 + (h)) * HTB)
#define G_STAGE(bufoff, gbase, voff) do { _Pragma("unroll") for (int _i = 0; _i < 2; ++_i) \
        __builtin_amdgcn_global_load_lds((const unsigned*)((const char*)(gbase) + (voff)[_i]), (LAS unsigned*)(lds + (bufoff) + ldsw + _i * 8192), 16, 0, 0); } while (0)
#define G_STAGE_A(b, h, p) do { if constexpr (Sched::GATHER) { G_STAGE(G_SA(b, h), (p), goff[h]); } else { G_STAGE(G_SA(b, h), (p) + ((h) ? hstepA : 0), voffA); } } while (0)
#define G_STAGE_B(b, h, p) G_STAGE(G_SB(b, h), (p) + ((h) ? hstepB : 0), voffB)
#define G_STAGE_B2(b, h, p, c2) do { if constexpr (Sched::BSPLIT) { unsigned vs_[2]; vs_[0] = (c2) ? voffB2[0] : voffB[0]; vs_[1] = (c2) ? voffB2[1] : voffB[1]; G_STAGE(G_SB(b, h), (p) + ((h) ? ((c2) ? hstepB2 : hstepB) : 0), vs_); } else G_STAGE_B(b, h, p); } while (0)
#define G_LDA(dst, b, h) do { _Pragma("unroll") for (int m = 0; m < 4; ++m) _Pragma("unroll") for (int k = 0; k < 2; ++k) dst[m][k] = *(const LAS bf16x8*)(lds + G_SA(b, h) + aoff + m * 2048 + k * 1024); } while (0)
#define G_LDB(dst, b, h) do { _Pragma("unroll") for (int n = 0; n < 2; ++n) _Pragma("unroll") for (int k = 0; k < 2; ++k) dst[n][k] = *(const LAS bf16x8*)(lds + G_SB(b, h) + boff + n * 2048 + k * 1024); } while (0)
#define G_MMA(ai, bj, At, Bt) do { __builtin_amdgcn_s_setprio(1); _Pragma("unroll") for (int m = 0; m < 4; ++m) _Pragma("unroll") for (int n = 0; n < 2; ++n) { \
        if constexpr (Sched::FP8) { const v8i a8_ = cat8(Bt[n][0], Bt[n][1]), b8_ = cat8(At[m][0], At[m][1]); \
            asm volatile("v_mfma_f32_16x16x128_f8f6f4 %0, %1, %2, %0" : "+v"(acc[ai][bj][m][n]) : "v"(a8_), "v"(b8_)); }     \
        else { _Pragma("unroll") for (int k = 0; k < 2; ++k) acc[ai][bj][m][n] = __builtin_amdgcn_mfma_f32_16x16x32_bf16(Bt[n][k], At[m][k], acc[ai][bj][m][n], 0, 0, 0); } } \
        __builtin_amdgcn_s_setprio(0); } while (0)
#define G_WAIT_V(n) asm volatile("s_waitcnt vmcnt(" #n ")" ::: "memory")
#define G_WAIT_L(n) asm volatile("s_waitcnt lgkmcnt(" #n ")" ::: "memory")
#define G_BAR __builtin_amdgcn_s_barrier()
#define G_SCHED __builtin_amdgcn_sched_barrier(0)
#define G_LOAD_GOFF(ui_, hm_) do { const LAS unsigned* _rl = S.rowlist(ui_) + ((hm_) == 2 ? 128 : 0); const int _r1 = (hm_) ? 0 : 128; _Pragma("unroll") for (int _i = 0; _i < 2; ++_i) { int _R, _C; stage_rc(tid * 16 + _i * 8192, _R, _C); \
        goff[0][_i] = ((_rl[_R] >> 1) & 0x7fffu) * 1024u + (unsigned)(_C * 2); goff[1][_i] = ((_rl[_r1 + _R] >> 1) & 0x7fffu) * 1024u + (unsigned)(_C * 2); } } while (0)
    Unit cur, nxt; int ui = 0;
    if (!S.next(0, cur)) return;
    f32x4 acc[2][2][4][2];
#pragma unroll
    for (int a = 0; a < 2; ++a)
#pragma unroll
        for (int b = 0; b < 2; ++b)
#pragma unroll
            for (int m = 0; m < 4; ++m)
#pragma unroll
                for (int n = 0; n < 2; ++n) acc[a][b][m][n] = (f32x4){0.f, 0.f, 0.f, 0.f};
    bf16x8 At[4][2], B0[2][2], B1[2][2];
    const char* cA = cur.A; const char* cB = cur.B; const char* cB2 = nullptr; if constexpr (Sched::BSPLIT) cB2 = cur.B2;
    if constexpr (Sched::KJUMP) { nt = cur.nt; kjump = cur.kjump; }
    int hm = 0; if constexpr (Sched::HALFM) hm = cur.hm;
    if constexpr (Sched::GATHER) { G_LOAD_GOFF(0, hm); LDS_WAIT(); }
    G_STAGE_B(0, 0, cB); G_STAGE_A(0, 0, cA); G_STAGE_B(0, 1, cB); G_STAGE_A(0, 1, cA);
    if (wr == 1) G_BAR;
    G_WAIT_V(4); G_BAR;
    G_STAGE_B(1, 0, cB + kstepB); G_STAGE_A(1, 0, cA + kstepA); G_STAGE_B(1, 1, cB + kstepB);
    G_WAIT_V(6); G_BAR;
    for (;;) {
        const bool has_next = S.next(ui + 1, nxt);
        const char* nA = has_next ? nxt.A : cA; const char* nB = has_next ? nxt.B : cB;
        for (int t = 0; t < nt; t += 2) {
            const bool last = (t == nt - 2);
#define KO_(kt) ((long)((kt) + ((Sched::KJUMP && (kt) >= 4) ? kjump : 0)))
            const char* a1 = cA + KO_(t + 1) * kstepA;
            const bool c2 = Sched::BSPLIT && !last && KO_(t + 2) >= 8, c3 = Sched::BSPLIT && !last && KO_(t + 3) >= 8;
            const char* a2 = last ? nA : cA + KO_(t + 2) * kstepA; const char* b2 = last ? nB : (c2 ? cB2 + (KO_(t + 2) - 8) * kstepB : cB + KO_(t + 2) * kstepB);
            const char* a3 = last ? nA + kstepA : cA + KO_(t + 3) * kstepA; const char* b3 = last ? nB + kstepB : (c3 ? cB2 + (KO_(t + 3) - 8) * kstepB : cB + KO_(t + 3) * kstepB);
#undef KO_
            G_LDB(B0, 0, 0); G_SCHED; G_LDA(At, 0, 0); G_STAGE_A(1, 1, a1);
            G_WAIT_L(8); G_BAR; G_WAIT_L(0); G_MMA(0, 0, At, B0); G_BAR; G_SCHED;
            if constexpr (!Sched::HALFN) G_LDB(B1, 0, 1);
            G_STAGE_B2(0, 0, b2, c2);
            if constexpr (Sched::GATHER) { if (last && has_next) { G_LOAD_GOFF(ui + 1, nxt.hm); } }
            G_BAR; G_WAIT_L(0); if constexpr (!Sched::HALFN) G_MMA(0, 1, At, B1); G_BAR;
            if (!(Sched::HALFM && hm)) G_LDA(At, 0, 1);
            G_STAGE_A(0, 0, a2);
            G_BAR; G_WAIT_L(0); if (!(Sched::HALFM && hm)) G_MMA(1, 0, At, B0); G_BAR; G_SCHED;
            G_STAGE_B2(0, 1, b2, c2);
            G_WAIT_V(6); G_BAR; if constexpr (!Sched::HALFN) { if (!(Sched::HALFM && hm)) G_MMA(1, 1, At, B1); } G_BAR;
            G_LDB(B0, 1, 0); G_SCHED; G_LDA(At, 1, 0); G_STAGE_A(0, 1, a2);
            G_WAIT_L(8); G_BAR; G_WAIT_L(0); G_MMA(0, 0, At, B0); G_BAR; G_SCHED;
            if constexpr (!Sched::HALFN) G_LDB(B1, 1, 1);
            G_STAGE_B2(1, 0, b3, c3);
            G_BAR; G_WAIT_L(0); if constexpr (!Sched::HALFN) G_MMA(0, 1, At, B1); G_BAR;
            if (!(Sched::HALFM && hm)) G_LDA(At, 1, 1);
            G_STAGE_A(1, 0, a3);
            G_BAR; G_WAIT_L(0); if (!(Sched::HALFM && hm)) G_MMA(1, 0, At, B0); G_BAR; G_SCHED;
            G_STAGE_B2(1, 1, b3, c3);
            G_WAIT_V(6); G_BAR; if constexpr (!Sched::HALFN) { if (!(Sched::HALFM && hm)) G_MMA(1, 1, At, B1); } G_BAR;
        }
        if constexpr (ALIGN_EPI) { if (wr == 0) G_BAR; }
        if constexpr (Sched::FP8) asm volatile("s_nop 15\n\ts_nop 15" ::: "memory");
        E(acc, cur, wr, wc, fr, fq);
#ifdef PROBE_EPI2
        if constexpr (Epi::PERM || true) { asm volatile("" ::: "memory"); if (!Epi::NOTIDEM) E(acc, cur, wr, wc, fr, fq); }
#endif
        if (!has_next) break;
#pragma unroll
        for (int a = 0; a < 2; ++a)
#pragma unroll
            for (int b = 0; b < 2; ++b)
#pragma unroll
                for (int m = 0; m < 4; ++m)
#pragma unroll
                    for (int n = 0; n < 2; ++n) acc[a][b][m][n] = (f32x4){0.f, 0.f, 0.f, 0.f};
        cur = nxt; cA = nA; cB = nB; if constexpr (Sched::BSPLIT) cB2 = cur.B2; ++ui; if constexpr (Sched::KJUMP) { nt = cur.nt; kjump = cur.kjump; } if constexpr (Sched::HALFM) hm = cur.hm;
        if constexpr (ALIGN_EPI) { if (wr == 1) G_BAR; }
    }
    G_WAIT_V(0);
    if constexpr (!ALIGN_EPI) { if (wr == 0) G_BAR; }
    G_BAR;
#undef G_SA
#undef G_SB
#undef G_STAGE
#undef G_STAGE_A
#undef G_STAGE_B
#undef G_STAGE_B2
#undef G_LDA
#undef G_LDB
#undef G_MMA
#undef G_WAIT_V
#undef G_WAIT_L
#undef G_BAR
#undef G_SCHED
#undef G_LOAD_GOFF
}

template <int AMODE  , bool F8 = false  >
struct RegSched {
    static constexpr int PID = AMODE; static constexpr bool KJUMP = false, HALFN = false;
    static constexpr bool GATHER = false, FP8 = F8, HALFM = false, BSPLIT = false;
    int nt; long kstepA, kstepB, hstepA, hstepB;
    const char* A; const char* B; long tstepA, tstepB; unsigned pitchA, pitchB;
    int nM, nN, nwg, G, c;
    __device__ __forceinline__ unsigned voffA(int R, int C) const { return AMODE == 0 ? (unsigned)R * pitchA + (unsigned)C * 2u : (unsigned)(C >> 4) * (unsigned)(NTOK * 32) + (unsigned)R * 32u + (unsigned)((C >> 3) & 1) * 16u; }
    __device__ __forceinline__ unsigned voffB(int Rb, int C) const { return (unsigned)Rb * pitchB + (unsigned)C * 2u; }
    __device__ __forceinline__ const LAS unsigned* rowlist(int) const { return nullptr; }
    __device__ __forceinline__ void init(const void* A_, const void* B_, int N, int K, int G_, int c_) {
        constexpr int ES = F8 ? 1 : 2;
        A = (const char*)A_; B = (const char*)B_; nt = K * ES / (BK * 2); nM = NTOK / BM; nN = N / BM; nwg = nM * nN; G = G_; c = c_;
        pitchB = (unsigned)K * ES; kstepB = BK * 2; hstepB = (long)HALF * K * ES; tstepB = 2 * hstepB;
        if (AMODE == 0) { pitchA = (unsigned)K * ES; kstepA = BK * 2; hstepA = (long)HALF * K * ES; tstepA = 2 * hstepA; }
        else { pitchA = 32u; kstepA = 4l * NTOK * 32; hstepA = HALF * 32; tstepA = BM * 32; }
    }
    __device__ __forceinline__ bool next(int i, Unit& u) const {
        const long L = (long)i * G + c; if (L >= nwg) return false;
        int wgid = (int)L; { const int q = nwg / NXCD, r = nwg % NXCD, xcd = wgid % NXCD, off = wgid / NXCD; wgid = (xcd < r ? xcd * (q + 1) : r * (q + 1) + (xcd - r) * q) + off; }
        const int nig = WGM * nN, gid = wgid / nig, fm = gid * WGM, gsz = (nM - fm) < WGM ? (nM - fm) : WGM;
        const int pm = fm + ((wgid % nig) % gsz), pn = (wgid % nig) / gsz;
        u.A = A + (long)pm * tstepA; u.B = B + (long)pn * tstepB; u.p0 = pm; u.p1 = pn; u.p2 = 0; u.p3 = 0; return true;
    }
};
template <int MODE>
struct SsmSched {
    static constexpr int PID = 2 + MODE; static constexpr bool KJUMP = (MODE == 1), HALFN = (MODE == 0);
    static constexpr bool GATHER = false, FP8 = false, HALFM = false, BSPLIT = (MODE == 1);
    int nt; long kstepA, kstepB, hstepA, hstepB, hstepB2;
    const char* A; const char* B; const char* B2s; int G, vcu, lim;
    __device__ __forceinline__ unsigned voffA(int R, int C) const { return (unsigned)R * (UPITCH * 2) + (unsigned)C * 2u; }
    __device__ __forceinline__ unsigned voffB(int Rb, int C) const { return MODE == 0 ? (unsigned)Rb * 1024u + (unsigned)C * 2u : (unsigned)(Rb & 15) * 2048u + (unsigned)(7 - (Rb >> 4)) * 32u + (unsigned)C * 2u; }
    __device__ __forceinline__ unsigned voffB2(int Rb, int C) const { return (unsigned)Rb * 256u + (unsigned)C * 2u; }
    __device__ __forceinline__ const LAS unsigned* rowlist(int) const { return nullptr; }
    __device__ __forceinline__ void init(const void* A_, const void* B_, int G_, int vcu_) {
        A = (const char*)A_; B = (const char*)B_; B2s = nullptr; G = G_; vcu = vcu_; lim = 1 << 20; kstepA = 128; kstepB = 128; hstepA = 128l * UPITCH * 2; hstepB2 = 128l * 256;
        if (MODE == 0) { nt = 8; hstepB = 0; } else { nt = 10; hstepB = -256; }
    }
    __device__ __forceinline__ bool next(int i, Unit& u) const {
        const int L = i * G + vcu;
        if (i >= lim) return false;
        if (MODE == 0) { if (L >= NGRP * 4) return false; const int g = L >> 2, pm = L & 3;
            u.A = A + ((long)g * NCH + pm * 256) * (UPITCH * 2); u.B = B + (long)g * (128 * 1024); u.p0 = g; u.p1 = pm; u.p2 = 0; u.p3 = 0; return true; }
        if (L >= NGRP * 8) return false; const int g = L >> 3, pm = (L >> 1) & 3, pn = (L ^ i) & 1;
        u.A = A + ((long)g * NCH + pm * 256) * (UPITCH * 2); u.B = B + (long)g * (16 * 2048) + (24 - 16 * pn) * 32; u.B2 = B2s + ((long)g * 512 + pn * 256) * 256l; u.p0 = g; u.p1 = pm; u.p2 = pn; u.p3 = 0;
        u.nt = pn == 0 ? 6 : 10; u.kjump = pn == 0 ? 4 : 0; return true;
    }
};
struct UnitRec { int e, rt, tg, pn; };
template <int MODE>
struct MoeSched {
    static constexpr int PID = 4 + MODE; static constexpr bool KJUMP = false, HALFN = false;
    static constexpr bool GATHER = (MODE == 0), FP8 = true, HALFM = true, BSPLIT = false;
    int nt; long kstepA, kstepB, hstepA, hstepB;
    const char* A; const char* B; const LAS UnitRec* ut; const LAS unsigned* lists; int nunits;
    __device__ __forceinline__ unsigned voffA(int R, int C) const { return (unsigned)R * 512u + (unsigned)C * 2u; }
    __device__ __forceinline__ unsigned voffB(int Rb, int C) const { return (unsigned)Rb * (MODE == 0 ? 1024u : 512u) + (unsigned)C * 2u; }
    __device__ __forceinline__ const LAS unsigned* rowlist(int ui) const { return lists + ui * 512; }
    __device__ __forceinline__ void init(const void* A_, const void* B_, const LAS UnitRec* ut_, const LAS unsigned* lists_, int nunits_) {
        A = (const char*)A_; B = (const char*)B_; ut = ut_; lists = lists_; nunits = nunits_; kstepA = 128; kstepB = 128;
        if (MODE == 0) { nt = 8; hstepA = 0; hstepB = 128l * 1024; } else { nt = 4; hstepA = 128l * 512; hstepB = 128l * 512; }
    }
    __device__ __forceinline__ bool next(int i, Unit& u) const {
        if (i >= nunits) return false;
        const int e = __builtin_amdgcn_readfirstlane(ut[i].e), tg = __builtin_amdgcn_readfirstlane(ut[i].tg), pnh = __builtin_amdgcn_readfirstlane(ut[i].pn), pn = pnh & 255, hm = pnh >> 8;
        if (MODE == 0) { u.A = A; u.B = B + ((long)e * 4 + pn) * (256l * 1024); }
        else { u.A = A + ((long)tg * 256 + (hm == 2 ? 128 : 0)) * 512l; u.B = B + ((long)e * 1024 + pn * 256) * 512l; }
        u.p0 = tg; u.p1 = pn; u.p2 = i; u.p3 = e; u.hm = hm; return true;
    }
};

typedef f32x4 AccT[2][2][4][2];
#define EPI_LOOP_AIM for (int ai = 0; ai < 2; ++ai) _Pragma("unroll") for (int m = 0; m < 4; ++m)
struct EpiInproj { static constexpr bool NOTIDEM = false; static constexpr bool PERM = true, PERM2 = false; bf16* UG;
    __device__ __forceinline__ void operator()(const AccT& acc, const Unit& u, int wr, int wc, int fr, int fq) const {
#pragma unroll
        EPI_LOOP_AIM { const int tok = u.p0 * 256 + ai * 128 + wr * 64 + m * 16 + fr;
#pragma unroll
            for (int bj = 0; bj < 2; ++bj) { const int g = u.p1 * 16 + bj * 8 + wc * 2 + (fq >> 1);
                bf16* dst = UG + ((size_t)g * NCH + (tok >> 5)) * UPITCH + (tok & 31) * 16 + (fq & 1) * 8;
                const f32x4 v0 = acc[ai][bj][m][0], v1 = acc[ai][bj][m][1];
                v4u w; w.x = cvt_pk_bf16(v0[0], v0[1]); w.y = cvt_pk_bf16(v0[2], v0[3]); w.z = cvt_pk_bf16(v1[0], v1[1]); w.w = cvt_pk_bf16(v1[2], v1[3]); *(v4u*)dst = w; } }
    } };
struct EpiS1 { static constexpr bool NOTIDEM = false; static constexpr bool PERM = true, PERM2 = false; bf16* SB;
    __device__ __forceinline__ void operator()(const AccT& acc, const Unit& u, int wr, int wc, int fr, int fq) const {
#pragma unroll
        EPI_LOOP_AIM { const int row = u.p1 * 256 + ai * 128 + wr * 64 + m * 16 + fr; bf16* dst = SB + ((size_t)u.p0 * NCH + row) * 128 + wc * 32 + 8 * fq;
            const f32x4 v0 = acc[ai][0][m][0], v1 = acc[ai][0][m][1];
            v4u w; w.x = cvt_pk_bf16(v0[0], v0[1]); w.y = cvt_pk_bf16(v0[2], v0[3]); w.z = cvt_pk_bf16(v1[0], v1[1]); w.w = cvt_pk_bf16(v1[2], v1[3]); *(v4u*)dst = w; }
    } };
struct EpiY { static constexpr bool NOTIDEM = false; static constexpr bool PERM = true, PERM2 = false; bf16* GG;
    __device__ __forceinline__ void operator()(const AccT& acc, const Unit& u, int wr, int wc, int fr, int fq) const {
        const f32x2 kc2 = {-0.10294324f, -0.10294324f}, kc1 = {-2.3022082f, -2.3022082f}, kone = {1.0f, 1.0f};
#pragma unroll
        EPI_LOOP_AIM { const int row = u.p1 * 256 + ai * 128 + wr * 64 + m * 16 + fr; bf16* dst = GG + ((size_t)u.p0 * NCH + row) * 512 + u.p2 * 256 + wc * 32 + 8 * fq;
#pragma unroll
            for (int bj = 0; bj < 2; ++bj) { const f32x4 v0 = acc[ai][bj][m][0], v1 = acc[ai][bj][m][1];
                const f32x2 g0 = gelu_tanh2((f32x2){v0[0], v0[1]}, kc2, kc1, kone), g1 = gelu_tanh2((f32x2){v0[2], v0[3]}, kc2, kc1, kone), g2 = gelu_tanh2((f32x2){v1[0], v1[1]}, kc2, kc1, kone), g3 = gelu_tanh2((f32x2){v1[2], v1[3]}, kc2, kc1, kone);
                v4u w; w.x = cvt_pk_bf16(g0[0], g0[1]); w.y = cvt_pk_bf16(g1[0], g1[1]); w.z = cvt_pk_bf16(g2[0], g2[1]); w.w = cvt_pk_bf16(g3[0], g3[1]); *(v4u*)(dst + bj * 128) = w; } }
    } };
struct EpiGlu { static constexpr bool PERM = true, PERM2 = false; const float* X0; bf16* XO; const float* gate1;
    __device__ __forceinline__ void operator()(const AccT& acc, const Unit& u, int wr, int wc, int fr, int fq) const {
        const int b = u.p0 >> 6, col0 = u.p1 * 128 + wc * 32 + 8 * fq;
        const size_t off0 = (size_t)(u.p0 * 256 + wr * 64 + fr) * D + col0;
        f32x4 xv[2][4][2];
#pragma unroll
        for (int ai = 0; ai < 2; ++ai)
#pragma unroll
            for (int m = 0; m < 4; ++m)
#pragma unroll
                for (int n = 0; n < 2; ++n) xv[ai][m][n] = __builtin_nontemporal_load((const f32x4*)(X0 + off0 + (size_t)(ai * 128 + m * 16) * D + n * 4));
        f32x4 gv[2];
#pragma unroll
        for (int n = 0; n < 2; ++n) { gv[n] = *(const f32x4*)(gate1 + b * 6144 + col0 + n * 4); gv[n] = gv[n] + 1.0f; }
#pragma unroll
        EPI_LOOP_AIM { float o[8];
#pragma unroll
            for (int n = 0; n < 2; ++n) { const f32x4 va = acc[ai][0][m][n], ga = acc[ai][1][m][n];
#pragma unroll
                for (int j = 0; j < 4; ++j) o[n * 4 + j] = xv[ai][m][n][j] + gv[n][j] * va[j] * sigmoidf_(ga[j]); }
            v4u w; w.x = cvt_pk_bf16(o[0], o[1]); w.y = cvt_pk_bf16(o[2], o[3]); w.z = cvt_pk_bf16(o[4], o[5]); w.w = cvt_pk_bf16(o[6], o[7]);
            *(v4u*)(XO + off0 + (size_t)(ai * 128 + m * 16) * D) = w; }
    } };
struct EpiCV { static constexpr bool NOTIDEM = false; static constexpr bool PERM = true, PERM2 = false; bf16* UU;
    __device__ __forceinline__ void operator()(const AccT& acc, const Unit& u, int wr, int wc, int fr, int fq) const {
#pragma unroll
        EPI_LOOP_AIM { bf16* dst = UU + (size_t)(u.p0 * 256 + ai * 128 + wr * 64 + m * 16 + fr) * D + u.p1 * 128 + wc * 32 + 8 * fq;
            const f32x4 c0 = acc[ai][0][m][0], c1 = acc[ai][0][m][1], v0 = acc[ai][1][m][0], v1 = acc[ai][1][m][1];
            constexpr float I2_ = 1.0f / (FS_XN * FS_WCI * FS_XN * FS_WCI);
            v4u w; w.x = cvt_pk_bf16(c0[0] * v0[0] * I2_, c0[1] * v0[1] * I2_); w.y = cvt_pk_bf16(c0[2] * v0[2] * I2_, c0[3] * v0[3] * I2_); w.z = cvt_pk_bf16(c1[0] * v1[0] * I2_, c1[1] * v1[1] * I2_); w.w = cvt_pk_bf16(c1[2] * v1[2] * I2_, c1[3] * v1[3] * I2_);
            *(v4u*)dst = w; }
    } };
struct EpiCin { static constexpr bool NOTIDEM = false; static constexpr bool PERM = true, PERM2 = false; bf16* UU; bf16* BG;
    __device__ __forceinline__ void operator()(const AccT& acc, const Unit& u, int wr, int wc, int fr, int fq) const {
        constexpr float I1_ = 1.0f / (FS_XN * FS_WCI), I2_ = I1_ * I1_;
        if (u.p1 < 8) {
#pragma unroll
            EPI_LOOP_AIM { bf16* dst = UU + (size_t)(u.p0 * 256 + ai * 128 + wr * 64 + m * 16 + fr) * D + u.p1 * 128 + wc * 32 + 8 * fq;
                const f32x4 c0 = acc[ai][0][m][0], c1 = acc[ai][0][m][1], v0 = acc[ai][1][m][0], v1 = acc[ai][1][m][1];
                v4u w; w.x = cvt_pk_bf16(c0[0] * v0[0] * I2_, c0[1] * v0[1] * I2_); w.y = cvt_pk_bf16(c0[2] * v0[2] * I2_, c0[3] * v0[3] * I2_); w.z = cvt_pk_bf16(c1[0] * v1[0] * I2_, c1[1] * v1[1] * I2_); w.w = cvt_pk_bf16(c1[2] * v1[2] * I2_, c1[3] * v1[3] * I2_);
                *(v4u*)dst = w; }
        } else {
#pragma unroll
            EPI_LOOP_AIM { bf16* dst = BG + (size_t)(u.p0 * 256 + ai * 128 + wr * 64 + m * 16 + fr) * D + (u.p1 - 8) * 256 + wc * 32 + 8 * fq;
#pragma unroll
                for (int bj = 0; bj < 2; ++bj) { const f32x4 v0 = acc[ai][bj][m][0] * I1_, v1 = acc[ai][bj][m][1] * I1_;
                    v4u w; w.x = cvt_pk_bf16(v0[0], v0[1]); w.y = cvt_pk_bf16(v0[2], v0[3]); w.z = cvt_pk_bf16(v1[0], v1[1]); w.w = cvt_pk_bf16(v1[2], v1[3]); *(v4u*)(dst + bj * 128) = w; } }
        }
    } };
struct EpiBf16 { static constexpr bool NOTIDEM = false; static constexpr bool PERM = true, PERM2 = false; bf16* O; int ldc;
    __device__ __forceinline__ void operator()(const AccT& acc, const Unit& u, int wr, int wc, int fr, int fq) const {
#pragma unroll
        EPI_LOOP_AIM { bf16* dst = O + (size_t)(u.p0 * 256 + ai * 128 + wr * 64 + m * 16 + fr) * ldc + u.p1 * 256 + wc * 32 + 8 * fq;
#pragma unroll
            for (int bj = 0; bj < 2; ++bj) { const f32x4 v0 = acc[ai][bj][m][0] * (1.0f / (FS_XN * FS_WCI)), v1 = acc[ai][bj][m][1] * (1.0f / (FS_XN * FS_WCI));
                v4u w; w.x = cvt_pk_bf16(v0[0], v0[1]); w.y = cvt_pk_bf16(v0[2], v0[3]); w.z = cvt_pk_bf16(v1[0], v1[1]); w.w = cvt_pk_bf16(v1[2], v1[3]); *(v4u*)(dst + bj * 128) = w; } }
    } };
struct EpiResid { static constexpr bool PERM = true, PERM2 = false; bf16* X; const float* gate1;
    __device__ __forceinline__ void operator()(const AccT& acc, const Unit& u, int wr, int wc, int fr, int fq) const {
        const int b = u.p0 >> 6, col0 = u.p1 * 256 + wc * 32 + 8 * fq;
        bf16* base = X + (size_t)(u.p0 * 256 + wr * 64 + fr) * D + col0;
        f32x4 gv[2][2];
#pragma unroll
        for (int bj = 0; bj < 2; ++bj)
#pragma unroll
            for (int n = 0; n < 2; ++n) { gv[bj][n] = *(const f32x4*)(gate1 + b * 6144 + col0 + bj * 128 + n * 4); gv[bj][n] = gv[bj][n] + 1.0f; }
#pragma unroll
        for (int ai = 0; ai < 2; ++ai) {
            v4u xq[4][2];
#pragma unroll
            for (int m = 0; m < 4; ++m)
#pragma unroll
                for (int bj = 0; bj < 2; ++bj) xq[m][bj] = *(const v4u*)(base + (size_t)(ai * 128 + m * 16) * D + bj * 128);
#pragma unroll
            for (int m = 0; m < 4; ++m) { bf16* rowp = base + (size_t)(ai * 128 + m * 16) * D;
#pragma unroll
                for (int bj = 0; bj < 2; ++bj) { const v4u q = xq[m][bj]; const f32x4 a0 = acc[ai][bj][m][0], a1 = acc[ai][bj][m][1];
                    v4u w; w.x = cvt_pk_bf16(bf_lo(q.x) + gv[bj][0][0] * a0[0], bf_hi(q.x) + gv[bj][0][1] * a0[1]); w.y = cvt_pk_bf16(bf_lo(q.y) + gv[bj][0][2] * a0[2], bf_hi(q.y) + gv[bj][0][3] * a0[3]);
                    w.z = cvt_pk_bf16(bf_lo(q.z) + gv[bj][1][0] * a1[0], bf_hi(q.z) + gv[bj][1][1] * a1[1]); w.w = cvt_pk_bf16(bf_lo(q.w) + gv[bj][1][2] * a1[2], bf_hi(q.w) + gv[bj][1][3] * a1[3]);
                    *(v4u*)(rowp + bj * 128) = w; } }
            asm volatile("" ::: "memory"); }
    } };
struct EpiMoe1 { static constexpr bool NOTIDEM = false; static constexpr bool PERM = true, PERM2 = false; unsigned char* HB;
    __device__ __forceinline__ void operator()(const AccT& acc, const Unit& u, int wr, int wc, int fr, int fq) const {
        constexpr float IA = 1.0f / (FS_XN * FS_W13), IB = FS_H / (FS_XN * FS_W13);
        const f32x2 kT = {-1.4426950408889634f * IA, -1.4426950408889634f * IA}, kAB = {IA * IB, IA * IB}, kone = {1.0f, 1.0f};
        const int roff = u.hm == 2 ? 128 : 0;
#pragma unroll
        for (int ai = 0; ai < 2; ++ai) if (!(ai && u.hm)) _Pragma("unroll") for (int m = 0; m < 4; ++m) { unsigned char* dst = HB + ((size_t)u.p0 * 256 + roff + ai * 128 + wr * 64 + m * 16 + fr) * DEXP + u.p1 * 128 + wc * 32 + 8 * fq;
            float h[8];
#pragma unroll
            for (int n = 0; n < 2; ++n)
#pragma unroll
                for (int p2 = 0; p2 < 2; ++p2) { const f32x2 ra = {acc[ai][0][m][n][2 * p2], acc[ai][0][m][n][2 * p2 + 1]}, rb = {acc[ai][1][m][n][2 * p2], acc[ai][1][m][n][2 * p2 + 1]};
                    const f32x2 r = rcp_2(pk_add(exp2_2(pk_mul(ra, kT)), kone)); const f32x2 hh = pk_mul(pk_mul(ra, rb), r);
                    h[4 * n + 2 * p2] = sat_fp8(hh[0]); h[4 * n + 2 * p2 + 1] = sat_fp8(hh[1]); }
            v2u w; w.x = pk4_fp8_div(h[0], h[1], h[2], h[3], 1.0f / (IA * IB)); w.y = pk4_fp8_div(h[4], h[5], h[6], h[7], 1.0f / (IA * IB)); *(v2u*)dst = w; }
    } };
struct EpiMoe2 { static constexpr bool NOTIDEM = false; static constexpr bool PERM = true, PERM2 = true; unsigned char* O2; const LAS unsigned* lists;
    __device__ __forceinline__ void operator()(const AccT& acc, const Unit& u, int wr, int wc, int fr, int fq) const {
        const LAS unsigned* sl = lists + u.p2 * 512;
        const int fr_ = fresh_lane() & 15;
        const int roff = u.hm == 2 ? 128 : 0;
#pragma unroll
        for (int ai = 0; ai < 2; ++ai) if (!(ai && u.hm)) _Pragma("unroll") for (int m = 0; m < 4; ++m) { const int r = roff + ai * 128 + wr * 64 + m * 16 + fr_; const float wt = __builtin_bit_cast(float, sl[256 + r]) * (FS_O / (FS_H * FS_W2));
            unsigned char* dst = O2 + ((size_t)u.p0 * 256 + r) * D + u.p1 * 256 + wc * 64 + 16 * fq; unsigned w4[4];
#pragma unroll
            for (int bj = 0; bj < 2; ++bj)
#pragma unroll
                for (int n = 0; n < 2; ++n) { const f32x4 v = acc[ai][bj][m][n] * wt; w4[bj * 2 + n] = pk4_fp8(sat_fp8(v[0]), sat_fp8(v[1]), sat_fp8(v[2]), sat_fp8(v[3])); }
            v4u w; w.x = w4[0]; w.y = w4[1]; w.z = w4[2]; w.w = w4[3]; *(v4u*)dst = w; }
    } };
}

enum { I_X = 0, I_C, I_ADAW, I_ADAB, I_N1G, I_N2G, I_SWIN, I_LRE, I_LIM, I_LDT, I_BRE, I_BIM, I_CRE, I_CIM, I_SD, I_SWGLU, I_CWIN, I_CW, I_CWOUT, I_WG, I_BGB, I_WE, I_BEB, I_W1, I_W3, I_W2, I_FG };
constexpr int NPH = 18;

template <bool FP8 = false, class RowPtr>
__device__ __forceinline__ void transpose_item(const float* W, int ldw, int k0, int n0, RowPtr rp, LAS float* scr, int lane, float fs = 1.0f) {
    float v[64];
    const float* src = W + (size_t)k0 * ldw + n0 + lane;
#pragma unroll
    for (int i = 0; i < 64; ++i) v[i] = __builtin_nontemporal_load(src + (size_t)i * ldw);
#pragma unroll
    for (int i = 0; i < 64; ++i) scr[i * 65 + lane] = v[i];
    LDS_WAIT(); asm volatile("" ::: "memory");
    const int c = lane & 7;
#pragma unroll
    for (int j = 0; j < 8; ++j) { const int n = (lane >> 3) + 8 * j; const LAS float* s = scr + (8 * c) * 65 + n;
        if constexpr (FP8) { v2u o; o.x = pk4_fp8(s[0 * 65] * fs, s[1 * 65] * fs, s[2 * 65] * fs, s[3 * 65] * fs); o.y = pk4_fp8(s[4 * 65] * fs, s[5 * 65] * fs, s[6 * 65] * fs, s[7 * 65] * fs);
            __builtin_nontemporal_store(o, (v2u*)(rp(n0 + n) + k0 + 8 * c)); }
        else { v4u o; o.x = pk2(s[0 * 65], s[1 * 65]); o.y = pk2(s[2 * 65], s[3 * 65]); o.z = pk2(s[4 * 65], s[5 * 65]); o.w = pk2(s[6 * 65], s[7 * 65]);
            __builtin_nontemporal_store(o, (v4u*)(rp(n0 + n) + k0 + 8 * c)); } }
    LDS_WAIT(); asm volatile("" ::: "memory");
}
constexpr int MOE_WITEMS = 12288;
__device__ __forceinline__ void moe_weight_item(const KArgs a, unsigned char* ws, int id, int le_base, LAS float* scr, int lane) {
    unsigned char* W13 = ws + WS_W13 + (size_t)(le_base >> 5) * (64 * MiB); unsigned char* W2T = ws + WS_W2 + (size_t)(le_base >> 5) * (32 * MiB);
    const int which = id >> 12, r = id & 4095, e = r >> 7, le = le_base + e;
    if (which < 2) { const int kb = (r >> 3) & 15, nb = r & 7;
        transpose_item<true>(a.in(which ? I_W3 : I_W1) + (size_t)le * 1024 * 512, 512, kb * 64, nb * 64, [&](int n) { return W13 + ((size_t)e * 1024 + (n >> 7) * 256 + which * 128 + (n & 127)) * 1024; }, scr, lane, FS_W13); }
    else { const int kb = (r >> 4) & 7, nb = r & 15;
        transpose_item<true>(a.in(I_W2) + (size_t)le * 512 * 1024, 1024, kb * 64, nb * 64, [&](int n) { return W2T + ((size_t)e * 1024 + n) * 512; }, scr, lane, FS_W2); }
}
constexpr int DEF_A = 2048, DEF_QB = 16, DEF_QC = 8;
__device__ __forceinline__ void deferred_items(const KArgs a, LAS unsigned char* lds, int first, int count, int slot, int nslots, int wave) {
    unsigned char* ws = a.ws(); LAS float* scr = (LAS float*)(lds + wave * 16640);
    const int lane = fresh_lane();
    for (int id = first + slot; id < first + count && id < MOE_WITEMS; id += nslots) moe_weight_item(a, ws, id, 32, scr, lane);
}
__device__ __forceinline__ void light_info(int P, int G, int bx, int& L, int& rank) {
    L = 0; rank = -1; if (G != 256) return;
    int nmax = 0;
    for (int x = 0; x < 8; ++x) { const int nx = 4 * (((x + 1) * P) / 8 - (x * P) / 8); const int rem = nx & 31; const int m = 2 * (nx >> 5) + (rem == 0 ? 0 : (rem <= 16 ? 1 : 2)); nmax = m > nmax ? m : nmax; }
    const int mx = bx & 7, mj = bx >> 3;
    for (int x = 0; x < 8; ++x) { const int nx = 4 * (((x + 1) * P) / 8 - (x * P) / 8); const int rem = nx & 31; const int m = 2 * (nx >> 5) + (rem == 0 ? 0 : (rem <= 16 ? 1 : 2));
        const int first_light = (m < nmax) ? 0 : (rem == 0 ? 32 : (rem <= 16 ? 2 * rem : rem));
        if (x == mx && mj >= first_light) rank = L + (mj - first_light);
        L += 32 - first_light; }
}
struct Cplx { float re, im; };
__device__ __forceinline__ Cplx lam_pow(float lr, float li, float dt, int tau) {
    const float mag = expf(lr * dt * (float)tau);
    const double ang = (double)li * (double)dt * (double)tau;
    const double nrev = __builtin_rint(ang * 0.15915494309189535);
    const float r = (float)(ang - nrev * 6.283185307179586);
    Cplx e; e.re = mag * cosf(r); e.im = mag * sinf(r); return e;
}
__device__ __forceinline__ float reduce16(const float (&v)[16], int lane) {
    float a[8], b[4], c[2], d;
    const bool b5 = lane & 32, b4 = lane & 16, b3 = lane & 8, b2 = lane & 4;
#pragma unroll
    for (int i = 0; i < 8; ++i) { const float keep = b5 ? v[2 * i + 1] : v[2 * i], send = b5 ? v[2 * i] : v[2 * i + 1]; a[i] = keep + shx(send, 32, lane); }
#pragma unroll
    for (int i = 0; i < 4; ++i) { const float keep = b4 ? a[2 * i + 1] : a[2 * i], send = b4 ? a[2 * i] : a[2 * i + 1]; b[i] = keep + shx(send, 16, lane); }
#pragma unroll
    for (int i = 0; i < 2; ++i) { const float keep = b3 ? b[2 * i + 1] : b[2 * i], send = b3 ? b[2 * i] : b[2 * i + 1]; c[i] = keep + shx(send, 8, lane); }
    { const float keep = b2 ? c[1] : c[0], send = b2 ? c[0] : c[1]; d = keep + shx(send, 4, lane); }
    d += shx(d, 2, lane); d += shx(d, 1, lane);
    return d;
}

__device__ __forceinline__ void p0_prologue(const KArgs a, LAS unsigned char* lds, int vcu, int G, int tid, int lane, int wave) {
    unsigned char* ws = a.ws();
    asm volatile("" : "+v"(tid)); lane = tid & 63;
    {
        LAS float* cond = (LAS float*)lds; LAS float* part = cond + 2048;
        __syncthreads();
        for (int i = tid; i < 2048; i += 512) { const float c = a.in(I_C)[i]; cond[i] = c / (1.0f + expf(-c)); }
        __syncthreads();
        float* mod = (float*)(ws + WS_MOD);
        for (int task = vcu; task < 256; task += G) {
            const int l = task >> 7, nb = task & 127;
            const float* W = a.in(I_ADAW) + (size_t)l * 1024 * 6144 + nb * 48 + (lane < 48 ? lane : 0);
            float a0 = 0.f, a1 = 0.f;
#pragma unroll 32
            for (int k = wave * 128; k < wave * 128 + 128; ++k) { const float w = __builtin_nontemporal_load(W + (size_t)k * 6144); a0 += cond[k] * w; a1 += cond[1024 + k] * w; }
            if (lane < 48) { part[(wave * 2 + 0) * 48 + lane] = a0; part[(wave * 2 + 1) * 48 + lane] = a1; }
            __syncthreads();
            if (tid < 96) { const int b = tid / 48, j = tid % 48; float s = 0.f;
#pragma unroll
                for (int w = 0; w < 8; ++w) s += part[(w * 2 + b) * 48 + j];
                const int n = nb * 48 + j; mod[(l * 2 + b) * 6144 + n] = s + a.in(I_ADAB)[l * 6144 + n]; }
            __syncthreads();
        }
    }
    LAS float* scr = (LAS float*)(lds + wave * 16640);
    const int gw = vcu * NWAVES + wave, NGW = G * NWAVES;
    bf16* WIN = (bf16*)(ws + WS_WIN); bf16* WGLU = (bf16*)(ws + WS_WGLU); bf16* WCIN = (bf16*)(ws + WS_WCIN); bf16* WCOUT = (bf16*)(ws + WS_WCOUT);
    bf16* BM_ = (bf16*)(ws + WS_BM); bf16* BT = (bf16*)(ws + WS_BT); bf16* CM_ = (bf16*)(ws + WS_CM); float* SC = (float*)(ws + WS_SC);
    constexpr int I0 = 256, I1 = 512, I2 = 768, I3 = 256, I4 = MOE_WITEMS, I7 = NGRP * 63, I8 = NGRP * 32, I9 = NGRP * 32, I10 = NGRP, I11 = 96;
    constexpr int NITEMS = I0 + I1 + I2 + I3 + I4 + I7 + I8 + I9 + I10 + I11;
    for (int it = gw; it < NITEMS; it += NGW) {
        int r = it;
        if (r < I0) { const int kb = r >> 4, nb = r & 15; transpose_item(a.in(I_SWIN), 1024, kb * 64, nb * 64, [&](int n) { return WIN + (size_t)n * 1024; }, scr, lane); continue; } r -= I0;
        if (r < I1) { const int kb = r >> 5, nb = r & 31;
            transpose_item(a.in(I_SWGLU), 2048, kb * 64, nb * 64, [&](int n) { const int half = n >> 10, nn = n & 1023; return WGLU + (size_t)((nn >> 7) * 256 + half * 128 + (nn & 127)) * 1024; }, scr, lane); continue; } r -= I1;
        if (r < I2) { const int kb = r / 48, nb = r % 48;
            transpose_item<true>(a.in(I_CWIN), 3072, kb * 64, nb * 64, [&](int n) { const int part = n >> 10, nn = n & 1023;
                const int row = part == 0 ? 2048 + nn : (nn >> 7) * 256 + (part - 1) * 128 + (nn & 127); return (unsigned char*)WCIN + (size_t)row * 1024; }, scr, lane, FS_WCI); continue; } r -= I2;
        if (r < I3) { const int kb = r >> 4, nb = r & 15; transpose_item(a.in(I_CWOUT), 1024, kb * 64, nb * 64, [&](int n) { return WCOUT + (size_t)n * 1024; }, scr, lane); continue; } r -= I3;
        if (r < I4) { moe_weight_item(a, ws, r, 0, scr, lane); continue; } r -= I4;
        if (r >= I7 + I8 + I9 + I10) {
            r -= I7 + I8 + I9 + I10; const int l = r / 48, n = r % 48; bf16* hrow = (bf16*)(ws + WS_WR) + ((size_t)(l * 2) * 48 + n) * 1024; bf16* lrow = hrow + 48 * 1024;
            for (int i = 0; i < 16; ++i) { const int k = lane + 64 * i; const float w = n < 4 ? a.in(I_WG)[((size_t)l * 1024 + k) * 4 + n] : (n < 36 ? a.in(I_WE)[((size_t)l * 1024 + k) * 32 + n - 4] : 0.f);
                const unsigned hb = f2bf(w); hrow[k] = (bf16)hb; lrow[k] = (bf16)f2bf(w - __builtin_bit_cast(float, hb << 16)); }
            continue; }
        int g, sub, kind;
        if (r < I7) { kind = 0; g = r / 63; sub = r % 63 - 31; } else { r -= I7; if (r < I8) { kind = 1; g = r >> 5; sub = r & 31; } else { r -= I8; if (r < I9) { kind = 2; g = r >> 5; sub = r & 31; } else { r -= I9; kind = 3; g = r; sub = 0; } } }
        const int p = lane;
        float crv[16], civ[16];
        if (kind == 0 && sub >= 0) {
#pragma unroll
            for (int s = 0; s < 16; ++s) { crv[s] = a.in(I_CRE)[(g * 16 + (lane & 15)) * 64 + 4 * s + (lane >> 4)]; civ[s] = a.in(I_CIM)[(g * 16 + (lane & 15)) * 64 + 4 * s + (lane >> 4)]; } }
        else if (kind == 1) {
#pragma unroll
            for (int k = 0; k < 16; ++k) { crv[k] = a.in(I_CRE)[(g * 16 + k) * 64 + p]; civ[k] = a.in(I_CIM)[(g * 16 + k) * 64 + p]; } }
        else {
#pragma unroll
            for (int k = 0; k < 16; ++k) { crv[k] = 0.f; civ[k] = 0.f; } }
        const float lr = a.in(I_LRE)[g * 64 + p], li = a.in(I_LIM)[g * 64 + p], dt = expf(a.in(I_LDT)[g]);
        if (kind == 3) { const Cplx e = lam_pow(lr, li, dt, LC); SC[(g * 64 + p) * 2] = e.re; SC[(g * 64 + p) * 2 + 1] = e.im; continue; }
        if (kind == 1) {
            const Cplx e = lam_pow(lr, li, dt, sub + 1);
#pragma unroll
            for (int k = 0; k < 16; ++k) { const float cr = crv[k], ci = civ[k];
                bf16* row = CM_ + ((size_t)g * 512 + sub * 16 + k) * 128; row[p] = (bf16)f2bf(cr * e.re - ci * e.im); row[64 + p] = (bf16)f2bf(-(cr * e.im + ci * e.re)); }
            continue; }
        const Cplx ab = lam_pow(lr, li, dt, 1);
        const float den = lr * lr + li * li, cfr = ((ab.re - 1.0f) * lr + ab.im * li) / den, cfi = (ab.im * lr - (ab.re - 1.0f) * li) / den;
        if (kind == 0 && sub < 0) {
            if (lane < 32) { const int k = (lane >> 1) & 15, half = lane & 1; *(v4u*)(BT + ((size_t)g * 16 + k) * 1024 + (31 - sub) * 16 + half * 8) = (v4u){0u, 0u, 0u, 0u}; }
            continue; }
        const Cplx e = lam_pow(lr, li, dt, kind == 0 ? sub : (LC - 1 - sub));
        float wre[16], wim[16];
        { const f32x4* brp = (const f32x4*)(a.in(I_BRE) + (size_t)(g * 64 + p) * 16); const f32x4* bip = (const f32x4*)(a.in(I_BIM) + (size_t)(g * 64 + p) * 16);
#pragma unroll
            for (int q = 0; q < 4; ++q) { const f32x4 br = brp[q], bi = bip[q];
#pragma unroll
                for (int j = 0; j < 4; ++j) { const float bbr = cfr * br[j] - cfi * bi[j], bbi = cfr * bi[j] + cfi * br[j]; wre[q * 4 + j] = e.re * bbr - e.im * bbi; wim[q * 4 + j] = e.re * bbi + e.im * bbr; } } }
        if (kind == 2) {
            bf16* r0 = BM_ + ((size_t)g * 128 + p) * 512 + sub * 16; bf16* r1 = r0 + 64 * 512;
            v4u o; o.x = pk2(wre[0], wre[1]); o.y = pk2(wre[2], wre[3]); o.z = pk2(wre[4], wre[5]); o.w = pk2(wre[6], wre[7]); *(v4u*)r0 = o;
            o.x = pk2(wre[8], wre[9]); o.y = pk2(wre[10], wre[11]); o.z = pk2(wre[12], wre[13]); o.w = pk2(wre[14], wre[15]); *(v4u*)(r0 + 8) = o;
            o.x = pk2(wim[0], wim[1]); o.y = pk2(wim[2], wim[3]); o.z = pk2(wim[4], wim[5]); o.w = pk2(wim[6], wim[7]); *(v4u*)r1 = o;
            o.x = pk2(wim[8], wim[9]); o.y = pk2(wim[10], wim[11]); o.z = pk2(wim[12], wim[13]); o.w = pk2(wim[14], wim[15]); *(v4u*)(r1 + 8) = o;
            continue; }
        {
#pragma unroll
            for (int q = 0; q < 4; ++q) { *(LAS f32x4*)(scr + p * 16 + 4 * q) = (f32x4){wre[4 * q], wre[4 * q + 1], wre[4 * q + 2], wre[4 * q + 3]};
                *(LAS f32x4*)(scr + 1024 + p * 16 + 4 * q) = (f32x4){wim[4 * q], wim[4 * q + 1], wim[4 * q + 2], wim[4 * q + 3]}; }
            LDS_WAIT(); asm volatile("" ::: "memory");
            const int kq = lane & 15, pq = lane >> 4;
            f32x4 acc = (f32x4){0.f, 0.f, 0.f, 0.f};
#pragma unroll
            for (int s = 0; s < 16; ++s) { const float wr = scr[(4 * s + pq) * 16 + kq], wi = scr[1024 + (4 * s + pq) * 16 + kq];
                acc = __builtin_amdgcn_mfma_f32_16x16x4f32(crv[s], wr, acc, 0, 0, 0); acc = __builtin_amdgcn_mfma_f32_16x16x4f32(-civ[s], wi, acc, 0, 0, 0); }
#pragma unroll
            for (int r_ = 0; r_ < 4; ++r_) { const int k = 4 * pq + r_; float m = acc[r_]; if (sub == 0 && k == kq) m += a.in(I_SD)[g * 16 + k];
                BT[((size_t)g * 16 + k) * 1024 + (31 - sub) * 16 + kq] = (bf16)f2bf(m); }
            LDS_WAIT(); asm volatile("" ::: "memory");
        }
    }
}

__device__ __forceinline__ void unpack8(const v4u q, float (&f)[8]) { f[0] = bf_lo(q.x); f[1] = bf_hi(q.x); f[2] = bf_lo(q.y); f[3] = bf_hi(q.y); f[4] = bf_lo(q.z); f[5] = bf_hi(q.z); f[6] = bf_lo(q.w); f[7] = bf_hi(q.w); }
__device__ __forceinline__ v4u pack8(const float (&f)[8]) { v4u o; o.x = pk2(f[0], f[1]); o.y = pk2(f[2], f[3]); o.z = pk2(f[4], f[5]); o.w = pk2(f[6], f[7]); return o; }
template <bool COMBINE, bool FINAL, bool XF32  >
__device__ __forceinline__ void norm_phase(const KArgs a, LAS unsigned char* lds, int vcu, int G, int tid, int lane, int wave,
                                           const void* xin, bf16* xio, float* outf, const float* gain, const float* modl  , int sh_idx  ,
                                           const float* modprev  ) {
    unsigned char* ws = a.ws();
    asm volatile("" : "+v"(tid)); lane = tid & 63;
    bf16* XN = (bf16*)(ws + WS_XN); const unsigned char* O2 = ws + WS_O2; const unsigned* ROWMAP = (const unsigned*)(ws + WS_ROWMAP);
    constexpr int RPI = (COMBINE || XF32) ? 2 : 4, NIT = 16 / RPI;
    for (int blk = vcu; blk < NTOK / 128; blk += G) {
        const int b = (blk * 128) >> 14;
        float gmv[2][8], shv[2][8], ggv[2][8];
#pragma unroll
        for (int j = 0; j < 2; ++j)
#pragma unroll
            for (int h = 0; h < 2; ++h) { const int c = 512 * j + 8 * lane + 4 * h; const f32x4 gn = *(const f32x4*)(gain + c); f32x4 gmq, shq;
                if constexpr (FINAL) { gmq = gn; shq = (f32x4){0.f, 0.f, 0.f, 0.f}; }
                else { const f32x4 sc = *(const f32x4*)(modl + b * 6144 + (sh_idx + 1) * 1024 + c); gmq = gn * (sc + 1.0f); shq = *(const f32x4*)(modl + b * 6144 + sh_idx * 1024 + c); }
#pragma unroll
                for (int q = 0; q < 4; ++q) { gmv[j][4 * h + q] = gmq[q]; shv[j][4 * h + q] = shq[q]; }
                if constexpr (COMBINE) { const f32x4 gq = (*(const f32x4*)(modprev + b * 6144 + 5 * 1024 + c) + 1.0f) * (1.0f / FS_O);
#pragma unroll
                    for (int q = 0; q < 4; ++q) ggv[j][4 * h + q] = gq[q]; } }
        typedef typename std::conditional<XF32, f32x4, v4u>::type XRaw; constexpr int XP = XF32 ? 2 : 1;
        XRaw rx[RPI][2][XP], nx[RPI][2][XP]; v2u ro0[COMBINE ? RPI : 1][2], ro1[COMBINE ? RPI : 1][2], no0[COMBINE ? RPI : 1][2], no1[COMBINE ? RPI : 1][2];
#define NORM_LOAD(dx, d0, d1, mbase) do { _Pragma("unroll") for (int rr = 0; rr < RPI; ++rr) _Pragma("unroll") for (int j = 0; j < 2; ++j) { const size_t m_ = (size_t)((mbase) + rr); \
            if constexpr (XF32) { dx[rr][j][0] = __builtin_nontemporal_load((const XRaw*)((const float*)xin + m_ * D + 512 * j + 8 * lane)); dx[rr][j][XP - 1] = __builtin_nontemporal_load((const XRaw*)((const float*)xin + m_ * D + 512 * j + 8 * lane + 4)); } \
            else { if constexpr (FINAL) dx[rr][j][0] = __builtin_nontemporal_load((const XRaw*)((const bf16*)xin + m_ * D + 512 * j + 8 * lane)); else dx[rr][j][0] = *(const XRaw*)((const bf16*)xin + m_ * D + 512 * j + 8 * lane); } \
            if constexpr (COMBINE) { const unsigned q0_ = (unsigned)__builtin_amdgcn_readlane((int)rmv, 2 * (int)(m_ - mw_)), q1_ = (unsigned)__builtin_amdgcn_readlane((int)rmv, 2 * (int)(m_ - mw_) + 1); d0[rr][j] = __builtin_nontemporal_load((const v2u*)(O2 + (size_t)q0_ * D + 512 * j + 8 * lane)); d1[rr][j] = __builtin_nontemporal_load((const v2u*)(O2 + (size_t)q1_ * D + 512 * j + 8 * lane)); } } } while (0)
        const size_t mw_ = (size_t)(blk * 128 + wave * 16); unsigned rmv = 0u; if constexpr (COMBINE) rmv = ROWMAP[2 * mw_ + (lane & 31)];
        NORM_LOAD(rx, ro0, ro1, blk * 128 + wave * 16);
        for (int it = 0; it < NIT; ++it) {
            const int m0 = blk * 128 + wave * 16 + RPI * it;
            if (it + 1 < NIT) NORM_LOAD(nx, no0, no1, m0 + RPI);
#pragma unroll
            for (int rr = 0; rr < RPI; ++rr) { const size_t m = (size_t)(m0 + rr); float h[2][8]; float ss = 0.f;
#pragma unroll
                for (int j = 0; j < 2; ++j) {
                    if constexpr (XF32) {
#pragma unroll
                        for (int q = 0; q < 4; ++q) { h[j][q] = rx[rr][j][0][q]; h[j][4 + q] = rx[rr][j][XP - 1][q]; } }
                    else unpack8(__builtin_bit_cast(v4u, rx[rr][j][0]), h[j]);
                    if constexpr (COMBINE) { float p0[8], p1[8]; unpack8_fp8(ro0[rr][j], p0); unpack8_fp8(ro1[rr][j], p1);
#pragma unroll
                        for (int q = 0; q < 8; ++q) h[j][q] += ggv[j][q] * (p0[q] + p1[q]);
                        if constexpr (!FINAL) *(v4u*)(xio + m * D + 512 * j + 8 * lane) = pack8(h[j]); }
#pragma unroll
                    for (int q = 0; q < 8; ++q) ss += h[j][q] * h[j][q]; }
                const float rstd = 1.0f / sqrtf(wave_sum(ss, lane) * (1.0f / D) + RMS_EPS);
#pragma unroll
                for (int j = 0; j < 2; ++j) {
#pragma unroll
                    for (int q = 0; q < 8; ++q) h[j][q] = h[j][q] * rstd * gmv[j][q] + shv[j][q];
                    if constexpr (FINAL) { __builtin_nontemporal_store((f32x4){h[j][0], h[j][1], h[j][2], h[j][3]}, (f32x4*)(outf + m * D + 512 * j + 8 * lane)); __builtin_nontemporal_store((f32x4){h[j][4], h[j][5], h[j][6], h[j][7]}, (f32x4*)(outf + m * D + 512 * j + 8 * lane + 4)); }
                    else if constexpr (COMBINE) { float q8[8];
#pragma unroll
                        for (int q = 0; q < 8; ++q) q8[q] = sat_fp8(h[j][q] * FS_XN);
                        v2u w8; w8.x = pk4_fp8(q8[0], q8[1], q8[2], q8[3]); w8.y = pk4_fp8(q8[4], q8[5], q8[6], q8[7]); *(v2u*)((unsigned char*)XN + m * D + 512 * j + 8 * lane) = w8; }
                    else *(v4u*)(XN + m * D + 512 * j + 8 * lane) = pack8(h[j]); } }
#pragma unroll
            for (int rr = 0; rr < RPI; ++rr)
#pragma unroll
                for (int j = 0; j < 2; ++j) {
#pragma unroll
                    for (int p = 0; p < XP; ++p) rx[rr][j][p] = nx[rr][j][p];
                    if constexpr (COMBINE) { ro0[rr][j] = no0[rr][j]; ro1[rr][j] = no1[rr][j]; } }
        }
#undef NORM_LOAD
    }
}

__device__ __forceinline__ void router_fold_row(const KArgs a, int row, int lane) {
    unsigned char* ws = a.ws();
    const int l = row / 96, b = (row / 48) & 1, n = row % 48;
    const bf16* wh = (const bf16*)(ws + WS_WR) + ((size_t)(l * 2) * 48 + n) * 1024 + lane * 16; const bf16* wl = wh + 48 * 1024;
    const float* gain = a.in(I_N2G) + l * 1024 + lane * 16; const float* md = (const float*)(ws + WS_MOD) + (size_t)(l * 2 + b) * 6144 + lane * 16;
    float acc = 0.f; unsigned o[8];
#pragma unroll
    for (int h = 0; h < 2; ++h) { float wv[8], lv[8]; unpack8(*(const v4u*)(wh + 8 * h), wv); unpack8(*(const v4u*)(wl + 8 * h), lv);
#pragma unroll
        for (int q = 0; q < 8; ++q) { const float w = wv[q] + lv[q]; acc += md[3 * 1024 + 8 * h + q] * w; wv[q] = w * gain[8 * h + q] * (1.0f + md[4 * 1024 + 8 * h + q]); }
#pragma unroll
        for (int q = 0; q < 4; ++q) o[4 * h + q] = pk2(wv[2 * q], wv[2 * q + 1]); }
    bf16* dst = (bf16*)(ws + WS_WRF) + ((size_t)(l * 2 + b) * 48 + n) * 1024 + lane * 16;
    *(v4u*)dst = (v4u){o[0], o[1], o[2], o[3]}; *(v4u*)(dst + 8) = (v4u){o[4], o[5], o[6], o[7]};
    acc = wave_sum(acc, lane);
    if (lane == 0) ((float*)(ws + WS_RBIAS))[row] = acc + (n < 4 ? a.in(I_BGB)[l * 4 + n] : (n < 36 ? a.in(I_BEB)[l * 32 + n - 4] : 0.f));
}

constexpr int LR_WH = 0, LR_WSTR = 1032, LR_GS = 99072, LR_RST = 107264, LR_LG = 107776;
__device__ __forceinline__ void router_phase(const KArgs a, LAS unsigned char* lds, int vcu, int G, int tid, int lane, int wave, const float* gain, const float* modl, int layer) {
    unsigned char* ws = a.ws();
    asm volatile("" : "+v"(tid)); lane = tid & 63;
    const bf16* XB = (const bf16*)(ws + WS_XB); unsigned char* XN = ws + WS_XN;
    LAS bf16* WH = (LAS bf16*)(lds + LR_WH); LAS float* GS = (LAS float*)(lds + LR_GS); LAS float* RST = (LAS float*)(lds + LR_RST) + wave * 16; LAS float* LG = (LAS float*)(lds + LR_LG) + wave * 768;
    LAS int* tokE = (LAS int*)(lds + L_TOK); LAS float* tokW = (LAS float*)(lds + L_TOK + 1024); LAS unsigned* lcnt = (LAS unsigned*)(lds + L_LCNT); LAS unsigned* lbase = lcnt + 32;
    for (int blk = vcu; blk < NTOK / 128; blk += G) {
        const int b = (blk * 128) >> 14;
        __syncthreads();
        { const bf16* WRF = (const bf16*)(ws + WS_WRF) + (size_t)(layer * 2 + b) * 48 * 1024;
#pragma unroll
          for (int i = 0; i < 12; ++i) { const int n = wave * 6 + (i >> 1), hf = i & 1;
              __builtin_amdgcn_global_load_lds((const unsigned*)(WRF + (size_t)n * 1024 + hf * 512 + lane * 8), (LAS unsigned*)(lds + LR_WH + n * (LR_WSTR * 2) + hf * 1024), 16, 0, 0); } }
        if (tid < 256) { const int c = 4 * tid; const f32x4 gn = *(const f32x4*)(gain + c), sc = *(const f32x4*)(modl + b * 6144 + 4 * 1024 + c); *(LAS f32x4*)(GS + c) = gn * (sc + 1.0f); }
        else { const int c = 4 * (tid - 256); *(LAS f32x4*)(GS + 1024 + c) = *(const f32x4*)(modl + b * 6144 + 3 * 1024 + c); }
        if (tid < 32) lcnt[tid] = 0u;
        LDS_WAIT(); __builtin_amdgcn_s_barrier();
        const int mw = blk * 128 + wave * 16;
        {
            float gmv[2][8], shv[2][8];
#pragma unroll
            for (int j = 0; j < 2; ++j)
#pragma unroll
                for (int h = 0; h < 2; ++h) { const f32x4 gq = *(const LAS f32x4*)(GS + 512 * j + 8 * lane + 4 * h), sq = *(const LAS f32x4*)(GS + 1024 + 512 * j + 8 * lane + 4 * h);
#pragma unroll
                    for (int q = 0; q < 4; ++q) { gmv[j][4 * h + q] = gq[q]; shv[j][4 * h + q] = sq[q]; } }
            v4u rx[4][2], nx[4][2];
#pragma unroll
            for (int rr = 0; rr < 4; ++rr)
#pragma unroll
                for (int j = 0; j < 2; ++j) rx[rr][j] = *(const v4u*)(XB + (size_t)(mw + rr) * D + 512 * j + 8 * lane);
            for (int it = 0; it < 4; ++it) {
                const int m0 = mw + 4 * it;
                if (it + 1 < 4) {
#pragma unroll
                    for (int rr = 0; rr < 4; ++rr)
#pragma unroll
                        for (int j = 0; j < 2; ++j) nx[rr][j] = *(const v4u*)(XB + (size_t)(m0 + 4 + rr) * D + 512 * j + 8 * lane); }
#pragma unroll
                for (int rr = 0; rr < 4; ++rr) { float h[2][8]; float ss = 0.f;
#pragma unroll
                    for (int j = 0; j < 2; ++j) { unpack8(rx[rr][j], h[j]);
#pragma unroll
                        for (int q = 0; q < 8; ++q) ss += h[j][q] * h[j][q]; }
                    const float rstd = 1.0f / sqrtf(wave_sum(ss, lane) * (1.0f / D) + RMS_EPS);
                    if (lane == 0) RST[4 * it + rr] = rstd;
#pragma unroll
                    for (int j = 0; j < 2; ++j) {
#pragma unroll
                        for (int q = 0; q < 8; ++q) h[j][q] = sat_fp8((h[j][q] * rstd * gmv[j][q] + shv[j][q]) * FS_XN);
                        v2u w8; w8.x = pk4_fp8(h[j][0], h[j][1], h[j][2], h[j][3]); w8.y = pk4_fp8(h[j][4], h[j][5], h[j][6], h[j][7]);
                        *(v2u*)(XN + (size_t)(m0 + rr) * D + 512 * j + 8 * lane) = w8; } }
#pragma unroll
                for (int rr = 0; rr < 4; ++rr)
#pragma unroll
                    for (int j = 0; j < 2; ++j) rx[rr][j] = nx[rr][j];
            }
        }
        LDS_WAIT(); asm volatile("" ::: "memory");
        asm volatile("s_waitcnt vmcnt(0)" ::: "memory"); __builtin_amdgcn_s_barrier();
        {
            const int fr = lane & 15, fq = lane >> 4;
            const bf16* xrow = XB + (size_t)(mw + fr) * D + fq * 8;
            f32x4 acc[3];
#pragma unroll
            for (int t = 0; t < 3; ++t) acc[t] = (f32x4){0.f, 0.f, 0.f, 0.f};
            {
                constexpr int kg = 0; v4u xq8[32];
#pragma unroll
                for (int u = 0; u < 32; ++u) xq8[u] = *(const v4u*)(xrow + (kg + u) * 32);
#pragma unroll
                for (int u = 0; u < 32; ++u) { const int k0 = (kg + u) * 32 + fq * 8; const bf16x8 ax = __builtin_bit_cast(bf16x8, xq8[u]);
#pragma unroll
                    for (int t = 0; t < 3; ++t) { const bf16x8 bh = *(const LAS bf16x8*)(WH + (t * 16 + fr) * LR_WSTR + k0);
                        acc[t] = __builtin_amdgcn_mfma_f32_16x16x32_bf16(ax, bh, acc[t], 0, 0, 0); } }
            }
            const float* rb = (const float*)(ws + WS_RBIAS) + (layer * 2 + b) * 48;
#pragma unroll
            for (int t = 0; t < 3; ++t) { const float bias = rb[t * 16 + fr];
#pragma unroll
                for (int r = 0; r < 4; ++r) LG[(4 * fq + r) * 48 + t * 16 + fr] = acc[t][r] * RST[4 * fq + r] + bias; }
        }
        LDS_WAIT(); asm volatile("" ::: "memory");
        if (lane < 16) {
            const LAS float* lg = LG + lane * 48;
            float gl[4]; int gi = 0;
#pragma unroll
            for (int j = 0; j < 4; ++j) gl[j] = lg[j];
            float gmax = gl[0];
#pragma unroll
            for (int j = 1; j < 4; ++j) if (gl[j] > gmax) { gmax = gl[j]; gi = j; }
            float gsum = 0.f;
#pragma unroll
            for (int j = 0; j < 4; ++j) gsum += expf(gl[j] - gmax);
            const float gp = 1.0f / gsum;
            float e0v = -3.0e38f, e1v = -3.0e38f; int e0 = 0, e1 = 0;
#pragma unroll
            for (int j = 0; j < 8; ++j) { const float v = lg[4 + gi * 8 + j];
                if (v > e0v) { e1v = e0v; e1 = e0; e0v = v; e0 = j; } else if (v > e1v) { e1v = v; e1 = j; } }
            const float dd = expf(e1v - e0v), w0 = gp / (1.0f + dd), w1 = gp * dd / (1.0f + dd);
            const int rl = wave * 16 + lane;
            tokE[rl * 2] = gi * 8 + e0; tokE[rl * 2 + 1] = gi * 8 + e1; tokW[rl * 2] = w0; tokW[rl * 2 + 1] = w1;
        }
        {
            unsigned* cntg = (unsigned*)(ws + WS_CTL) + CW_CNT + layer * 32; unsigned* listi = (unsigned*)(ws + WS_LISTI); float* listw = (float*)(ws + WS_LISTW);
            __syncthreads();
            int e = 0; unsigned rank = 0;
            if (tid < 256) { e = tokE[tid]; rank = atomicAdd((unsigned*)&lcnt[e], 1u); }
            __syncthreads();
            if (tid < 32) { const unsigned n = lcnt[tid]; lbase[tid] = n ? atomicAdd(&cntg[tid], n) : 0u; }
            __syncthreads();
            if (tid < 256) { const unsigned pos = lbase[e] + rank; const unsigned m = (unsigned)(blk * 128 + (tid >> 1));
                listi[(size_t)e * NTOK + pos] = m * 2u + (unsigned)(tid & 1); listw[(size_t)e * NTOK + pos] = tokW[tid]; }
        }
    }
}

__device__ __forceinline__ void scan_phase(const KArgs a, LAS unsigned char* lds, int task0, int task1, int tstep, int lane, int wave) {
    unsigned char* ws = a.ws();
    asm volatile("" : "+v"(lane));
    const bf16* SB = (const bf16*)(ws + WS_SB); bf16* UG = (bf16*)(ws + WS_UG); const float* SC = (const float*)(ws + WS_SC);
    LAS float* ex = (LAS float*)lds;
    for (int task = task0; task < task1; task += tstep) {
        const int b = task & 1, g = task >> 1, p = lane;
        const float ar = SC[(g * 64 + p) * 2], ai = SC[(g * 64 + p) * 2 + 1];
        const bf16* sp = SB + ((size_t)g * NCH + b * 512 + wave * 64) * 128 + p; bf16* up = UG + ((size_t)g * NCH + b * 512 + wave * 64) * UPITCH + 512 + p;
        float er = 0.f, ei = 0.f;
#pragma unroll 1
        for (int jb = 0; jb < 64; jb += 32) { float sr[32], si[32];
#pragma unroll
            for (int j = 0; j < 32; ++j) { sr[j] = __builtin_bit_cast(float, (unsigned)sp[(size_t)(jb + j) * 128] << 16); si[j] = __builtin_bit_cast(float, (unsigned)sp[(size_t)(jb + j) * 128 + 64] << 16); }
#pragma unroll
            for (int j = 0; j < 32; ++j) { const float nr = ar * er - ai * ei + sr[j], ni = ar * ei + ai * er + si[j]; er = nr; ei = ni; } }
        ex[(wave * 2) * 64 + p] = er; ex[(wave * 2 + 1) * 64 + p] = ei;
        float a64r = ar, a64i = ai;
#pragma unroll
        for (int s = 0; s < 6; ++s) { const float nr = a64r * a64r - a64i * a64i, ni = 2.0f * a64r * a64i; a64r = nr; a64i = ni; }
        __syncthreads();
        float hr = 0.f, hi = 0.f;
        for (int w = 0; w < wave; ++w) { const float qr = ex[(w * 2) * 64 + p], qi = ex[(w * 2 + 1) * 64 + p]; const float nr = a64r * hr - a64i * hi + qr, ni = a64r * hi + a64i * hr + qi; hr = nr; hi = ni; }
#pragma unroll 1
        for (int jb = 0; jb < 64; jb += 32) { float sr[32], si[32];
#pragma unroll
            for (int j = 0; j < 32; ++j) { sr[j] = __builtin_bit_cast(float, (unsigned)sp[(size_t)(jb + j) * 128] << 16); si[j] = __builtin_bit_cast(float, (unsigned)sp[(size_t)(jb + j) * 128 + 64] << 16); }
#pragma unroll
            for (int j = 0; j < 32; ++j) { up[(size_t)(jb + j) * UPITCH] = (bf16)f2bf(hr); up[(size_t)(jb + j) * UPITCH + 64] = (bf16)f2bf(hi);
                const float nr = ar * hr - ai * hi + sr[j], ni = ar * hi + ai * hr + si[j]; hr = nr; hi = ni; } }
        __syncthreads();
    }
}

__device__ __forceinline__ void conv_phase(const KArgs a, int vcu, int G, int tid) {
    unsigned char* ws = a.ws();
    const bf16* BG = (const bf16*)(ws + WS_BG); const bf16* UU = (const bf16*)(ws + WS_UU); bf16* A3 = (bf16*)(ws + WS_A3);
    asm volatile("" : "+v"(tid));
    const int cg = tid & 127, rq = tid >> 7; const float* cw = a.in(I_CW);
    float w0[8], w1[8], w2[8];
#pragma unroll
    for (int j = 0; j < 8; ++j) { w0[j] = cw[cg * 8 + j]; w1[j] = cw[1024 + cg * 8 + j]; w2[j] = cw[2048 + cg * 8 + j]; }
    for (int blk = vcu; blk < NTOK / 128; blk += G) {
        const int m0 = blk * 128 + rq * 32; const int t0 = m0 & (SEQ - 1);
        float u1[8], u2[8];
#pragma unroll
        for (int j = 0; j < 8; ++j) { u1[j] = 0.f; u2[j] = 0.f; }
        if (t0 >= 1) { const v4u q = *(const v4u*)(UU + (size_t)(m0 - 1) * D + cg * 8); u1[0] = bf_lo(q.x); u1[1] = bf_hi(q.x); u1[2] = bf_lo(q.y); u1[3] = bf_hi(q.y); u1[4] = bf_lo(q.z); u1[5] = bf_hi(q.z); u1[6] = bf_lo(q.w); u1[7] = bf_hi(q.w); }
        if (t0 >= 2) { const v4u q = *(const v4u*)(UU + (size_t)(m0 - 2) * D + cg * 8); u2[0] = bf_lo(q.x); u2[1] = bf_hi(q.x); u2[2] = bf_lo(q.y); u2[3] = bf_hi(q.y); u2[4] = bf_lo(q.z); u2[5] = bf_hi(q.z); u2[6] = bf_lo(q.w); u2[7] = bf_hi(q.w); }
        v4u qq[8], bqq[8], nq[8], nbq[8];
#pragma unroll
        for (int r = 0; r < 8; ++r) { const size_t off = (size_t)(m0 + r) * D + cg * 8; qq[r] = __builtin_nontemporal_load((const v4u*)(UU + off)); bqq[r] = __builtin_nontemporal_load((const v4u*)(BG + off)); }
        for (int r0 = 0; r0 < 32; r0 += 8) {
            if (r0 + 8 < 32) {
#pragma unroll
                for (int r = 0; r < 8; ++r) { const size_t off = (size_t)(m0 + r0 + 8 + r) * D + cg * 8; nq[r] = __builtin_nontemporal_load((const v4u*)(UU + off)); nbq[r] = __builtin_nontemporal_load((const v4u*)(BG + off)); } }
#pragma unroll
            for (int r = 0; r < 8; ++r) { const size_t off = (size_t)(m0 + r0 + r) * D + cg * 8; const v4u q = qq[r], bq = bqq[r];
                float u0[8], bb[8], z[8];
                u0[0] = bf_lo(q.x); u0[1] = bf_hi(q.x); u0[2] = bf_lo(q.y); u0[3] = bf_hi(q.y); u0[4] = bf_lo(q.z); u0[5] = bf_hi(q.z); u0[6] = bf_lo(q.w); u0[7] = bf_hi(q.w);
                bb[0] = bf_lo(bq.x); bb[1] = bf_hi(bq.x); bb[2] = bf_lo(bq.y); bb[3] = bf_hi(bq.y); bb[4] = bf_lo(bq.z); bb[5] = bf_hi(bq.z); bb[6] = bf_lo(bq.w); bb[7] = bf_hi(bq.w);
#pragma unroll
                for (int j = 0; j < 8; ++j) { z[j] = bb[j] * (w0[j] * u2[j] + w1[j] * u1[j] + w2[j] * u0[j]); u2[j] = u1[j]; u1[j] = u0[j]; }
                v4u o; o.x = pk2(z[0], z[1]); o.y = pk2(z[2], z[3]); o.z = pk2(z[4], z[5]); o.w = pk2(z[6], z[7]); *(v4u*)(A3 + off) = o; }
#pragma unroll
            for (int r = 0; r < 8; ++r) { qq[r] = nq[r]; bqq[r] = nbq[r]; }
        }
    }
}

template <int MODE>
__device__ __forceinline__ int moe_setup(const KArgs a, LAS unsigned char* lds, int G, int bx, int tid, int layer) {
    unsigned char* ws = a.ws();
    const unsigned* cntg = (const unsigned*)(ws + WS_CTL) + CW_CNT + layer * 32; const unsigned* listi = (const unsigned*)(ws + WS_LISTI); const unsigned* listw = (const unsigned*)(ws + WS_LISTW);
    asm volatile("" : "+v"(tid));
    LAS int* lc = (LAS int*)(lds + L_CNT); LAS int* tb = lc + 32; LAS int* nun = tb + 34;
    LAS gm::UnitRec* ut = (LAS gm::UnitRec*)(lds + L_UT); LAS unsigned* lists = (LAS unsigned*)(lds + L_LIST);
#if !MK_MULTI
    if (MODE == 1) return nun[0];
#endif
    if (tid < 64) {
        const int lane = tid, ex = lane & 31;
        const int c = (int)__hip_atomic_load(cntg + ex, __ATOMIC_RELAXED, __HIP_MEMORY_SCOPE_AGENT);
        const int tl = (c + 255) >> 8; int incl = tl;
#pragma unroll
        for (int o = 1; o < 32; o <<= 1) { const int t = shi(incl, lane - o, lane); if (ex >= o) incl += t; }
        const int excl = incl - tl, total = shi(incl, (lane & 32) + 31, lane);
        if (lane < 32) { lc[lane] = c; tb[lane] = excl; }
        const int U = total * 4; int start, end, stride, j;
        if ((G & 7) == 0) { const int x = bx & 7; start = 4 * ((x * total) / 8); end = 4 * (((x + 1) * total) / 8); stride = G >> 3; j = bx >> 3; } else { start = 0; end = U; stride = G; j = bx; }
        const int nxu = end - start, rounds = nxu / stride, rem = nxu - rounds * stride; const bool split = rem > 0 && 2 * rem <= stride;
        int uu = start + j + lane * stride, hm = 0; bool valid = lane < MAXU && lane < rounds;
        if (lane == rounds) { if (split) { uu = start + rounds * stride + (j >> 1); hm = 1 + (j & 1); valid = (j < 2 * rem) && lane < MAXU; } else valid = (j < rem) && lane < MAXU; }
        const int tg = uu >> 2, pn = uu & 3; int ee = 0;
#pragma unroll
        for (int k = 0; k < 31; ++k) ee += (shi(incl, (lane & 32) + k, lane) <= tg) ? 1 : 0;
        const int rt = tg - shi(excl, (lane & 32) + ee, lane);
        if (valid) { ut[lane].e = ee; ut[lane].rt = rt; ut[lane].tg = tg; ut[lane].pn = pn | (hm << 8); }
        const int n = __builtin_popcountll(__ballot(valid));
        if (lane == 0) { nun[0] = n; int L_, rk_; light_info(total, G, bx, L_, rk_); nun[1] = L_; nun[2] = rk_; }
    }
    __syncthreads();
    const int n = nun[0];
    for (int idx = tid; idx < n * 256; idx += 512) { const int ui = idx >> 8, r = idx & 255; const int e = ut[ui].e, pos = ut[ui].rt * 256 + r; const bool ok = pos < lc[e];
        const unsigned v = ok ? listi[(size_t)e * NTOK + pos] : 0xffffffffu;
        lists[ui * 512 + r] = v; lists[ui * 512 + 256 + r] = ok ? listw[(size_t)e * NTOK + pos] : 0u;
        if (ok && (ut[ui].pn & 255) == 0) ((unsigned*)(ws + WS_ROWMAP))[v] = (unsigned)(ut[ui].tg * 256 + r); }
    __syncthreads();
    return n;
}

template <int LO, int HI>
__global__ void __launch_bounds__(NWAVES * 64, 2) fwd_kernel(Args args) {
    extern __shared__ __attribute__((aligned(16))) unsigned char lds_raw[];
    LAS unsigned char* lds = (LAS unsigned char*)lds_raw;
    const int wave = __builtin_amdgcn_readfirstlane((int)threadIdx.x >> 6); const int tid0_ = threadIdx.x;
    const int G = gridDim.x; int bx = blockIdx.x; int vcu = (G % 8 == 0) ? (bx % 8) * (G / 8) + bx / 8 : bx; int lok = 0;
    volatile LAS unsigned* MISC = (volatile LAS unsigned*)(lds + L_MISC);
    if (tid0_ < 32) MISC[tid0_] = 0u;
    __syncthreads();
    XcdBarrier bar; bar.bar = nullptr; bar.x = 0; bar.st = nullptr;
    if constexpr (HI - LO > 1) bar = xcd_barrier_post((unsigned*)(args.ws + WS_CTL) + CW_BAR, MISC + 8, wave);
#define GRID_BAR() do { XcdBarrier b_ = bar; asm volatile("" : "+s"(b_.bar), "+s"(b_.x)); xcd_barrier<false>(b_, wave); } while (0)
#define XCD_BAR() do { XcdBarrier b_ = bar; asm volatile("" : "+s"(b_.bar), "+s"(b_.x)); xcd_barrier<true>(b_, wave); } while (0)
    constexpr int lo = LO, hi = HI;
#ifndef PHM
#define PHM 0x3ffff
#endif
#define EN(s) (((PHM) >> (s)) & 1)
#ifndef DBLM
#define DBLM 0
#endif
#define REP(s) for (int rep_ = 0; rep_ < 1 + (((DBLM) >> (s)) & 1); ++rep_)
#define IN(k) (lo <= (k) && (k) < hi)
#define SEAM(k) do { if (IN(k) && IN((k) + 1)) GRID_BAR(); } while (0)
#define SEAM_L(k) do { if (IN(k) && IN((k) + 1)) XCD_BAR(); } while (0)
#define PHASE_ARGS const int lane = fresh_lane(), tid = wave * 64 + lane; (void)tid; const KArgs a = fresh_args(); unsigned char* const ws = a.ws(); const float* const mod = (const float*)(ws + WS_MOD); (void)mod

    if (EN(0) && IN(0)) REP(0) { PHASE_ARGS; p0_prologue(a, lds, vcu, G, tid, lane, wave); } SEAM(0);
    if constexpr (HI - LO > 1) if (IN(0) && IN(1)) { lok = __builtin_amdgcn_readfirstlane((int)MISC[8 + 2]);
        if (lok) { const int rk_ = __builtin_amdgcn_readfirstlane((int)MISC[8 + 3]), x_ = (int)bar.x; vcu = x_ * 32 + rk_; bx = rk_ * 8 + x_; } }

    if (EN(1) && IN(1)) REP(1) { PHASE_ARGS; if (wave == 0) for (int row_ = vcu; row_ < 192; row_ += G) router_fold_row(a, row_, lane);
        norm_phase<false, false, true>(a, lds, vcu, G, tid, lane, wave, a.in(I_X), nullptr, nullptr, a.in(I_N1G), mod, 0, nullptr); } SEAM_L(1);
    if (EN(2) && IN(2)) REP(2) { PHASE_ARGS; gm::RegSched<0> S; S.init(ws + WS_XN, ws + WS_WIN, 1024, 1024, G, bx); gm::EpiInproj E{(bf16*)(ws + WS_UG)};
        gm::gemm_phase<gm::EpiInproj, gm::RegSched<0>, true>(lds, S, E, wave); } SEAM(2);
    if (EN(3) && IN(3)) REP(3) { PHASE_ARGS; gm::SsmSched<0> S; S.init(ws + WS_UG, ws + WS_BM, G, vcu); gm::EpiS1 E{(bf16*)(ws + WS_SB)};
        gm::gemm_phase<gm::EpiS1, gm::SsmSched<0>, true>(lds, S, E, wave); } SEAM_L(3);
    if (EN(4) && IN(4)) REP(4) { PHASE_ARGS;
        if (lok) { const int x_ = vcu >> 5, rk_ = vcu & 31;
            if (rk_ < 16) scan_phase(a, lds, 16 * x_ + rk_, 16 * x_ + rk_ + 1, 1, lane, wave);
            else deferred_items(a, lds, 0, DEF_A, (x_ * 16 + rk_ - 16) * NWAVES + wave, 128 * NWAVES, wave); }
        else { scan_phase(a, lds, vcu, 2 * NGRP, G, lane, wave);
            if (G == 256 && vcu >= 128) deferred_items(a, lds, 0, DEF_A, (vcu - 128) * NWAVES + wave, 128 * NWAVES, wave); } } SEAM_L(4);
    if (EN(5) && IN(5)) REP(5) { PHASE_ARGS; gm::SsmSched<1> S; S.init(ws + WS_UG, ws + WS_BT, G, vcu); S.B2s = (const char*)(ws + WS_CM); if (lok) { S.G = 32; S.vcu = (vcu >> 5) * 64 + (vcu & 31); S.lim = 2; } gm::EpiY E{(bf16*)(ws + WS_GG)};
        gm::gemm_phase<gm::EpiY, gm::SsmSched<1>, true>(lds, S, E, wave); } SEAM(5);
    if (EN(6) && IN(6)) REP(6) { PHASE_ARGS; gm::RegSched<1> S; S.init(ws + WS_GG, ws + WS_WGLU, 2048, 1024, G, bx); gm::EpiGlu E{a.in(I_X), (bf16*)(ws + WS_XB), mod + 2 * 1024};
        gm::gemm_phase<gm::EpiGlu, gm::RegSched<1>, true>(lds, S, E, wave); } SEAM_L(6);

    for (int l = 0; l < 2; ++l) {
        const int pb = 7 + 7 * l;
        int z0_ = 0; asm volatile("" : "+s"(z0_)); LAS unsigned char* const lds_l = lds + z0_;
        if (l == 1) {
            if (EN(10) && IN(10)) REP(10) { PHASE_ARGS;
                {
                    LAS int* nun_ = (LAS int*)(lds_l + L_CNT) + 66;
                    if (tid == 0) { const unsigned* cntg = (const unsigned*)(ws + WS_CTL) + CW_CNT; int tot = 0; for (int e_ = 0; e_ < 32; ++e_) tot += (int)((__hip_atomic_load(cntg + e_, __ATOMIC_RELAXED, __HIP_MEMORY_SCOPE_AGENT) + 255u) >> 8);
                        int L_, rk_; light_info(tot, G, bx, L_, rk_); nun_[1] = L_; }
                    __syncthreads();
                    const int done_ = ((G == 256) ? DEF_A : 0) + nun_[1] * (DEF_QB + DEF_QC);
                    deferred_items(a, lds_l, done_, MOE_WITEMS - done_, vcu * NWAVES + wave, G * NWAVES, wave);
                    __syncthreads();
                }
                norm_phase<true, false, false>(a, lds_l, vcu, G, tid, lane, wave, ws + WS_XB, (bf16*)(ws + WS_XB), nullptr, a.in(I_N1G) + 1024, mod + 2 * 6144, 0, mod); } SEAM_L(10);
            if (EN(11) && IN(11)) REP(11) {
                { PHASE_ARGS; gm::RegSched<0, true> S; S.init(ws + WS_XN, ws + WS_WCIN, 3072, 1024, G, bx); gm::EpiCin E{(bf16*)(ws + WS_UU), (bf16*)(ws + WS_BG)};
                  gm::gemm_phase<gm::EpiCin, gm::RegSched<0, true>, true>(lds_l, S, E, wave); }
            } SEAM(11);
            if (EN(12) && IN(12)) REP(12) { PHASE_ARGS; conv_phase(a, vcu, G, tid); } SEAM_L(12);
            if (EN(13) && IN(13)) REP(13) { PHASE_ARGS; gm::RegSched<0> S; S.init(ws + WS_A3, ws + WS_WCOUT, 1024, 1024, G, bx); gm::EpiResid E{(bf16*)(ws + WS_XB), mod + 2 * 6144 + 2 * 1024};
                gm::gemm_phase<gm::EpiResid, gm::RegSched<0>, true>(lds_l, S, E, wave); } SEAM_L(13);
        }
        if (EN(7) && IN(pb)) REP(7) { PHASE_ARGS; router_phase(a, lds_l, vcu, G, tid, lane, wave, a.in(I_N2G) + l * 1024, mod + l * 2 * 6144, l); } SEAM(pb);
        if (EN(8) && IN(pb + 1)) REP(8) { PHASE_ARGS; const int n = moe_setup<0>(a, lds_l, G, bx, tid, l);
            gm::MoeSched<0> S; S.init(ws + WS_XN, ws + WS_W13 + (size_t)l * 32 * 4 * 256 * 2048, (const LAS gm::UnitRec*)(lds_l + L_UT), (const LAS unsigned*)(lds_l + L_LIST), n);
            gm::EpiMoe1 E{ws + WS_HB};
            gm::gemm_phase<gm::EpiMoe1, gm::MoeSched<0>, true>(lds_l, S, E, wave);
            if (l == 0) { LAS int* nun_ = (LAS int*)(lds_l + L_CNT) + 66; const int rk_ = nun_[2]; const int doneA = (G == 256) ? DEF_A : 0;
                if (rk_ >= 0) deferred_items(a, lds_l, doneA + rk_ * DEF_QB, DEF_QB, wave, NWAVES, wave); } } SEAM_L(pb + 1);
        if (EN(9) && IN(pb + 2)) REP(9) { PHASE_ARGS; const int n = moe_setup<1>(a, lds_l, G, bx, tid, l);
            gm::MoeSched<1> S; S.init(ws + WS_HB, ws + WS_W2 + (size_t)l * 32 * 1024 * 1024, (const LAS gm::UnitRec*)(lds_l + L_UT), (const LAS unsigned*)(lds_l + L_LIST), n);
            gm::EpiMoe2 E{ws + WS_O2, (const LAS unsigned*)(lds_l + L_LIST)};
            gm::gemm_phase<gm::EpiMoe2, gm::MoeSched<1>, true>(lds_l, S, E, wave);
            if (l == 0) { LAS int* nun_ = (LAS int*)(lds_l + L_CNT) + 66; const int L_ = nun_[1], rk_ = nun_[2]; const int doneA = (G == 256) ? DEF_A : 0;
                if (rk_ >= 0) deferred_items(a, lds_l, doneA + L_ * DEF_QB + rk_ * DEF_QC, DEF_QC, wave, NWAVES, wave); } } SEAM(pb + 2);
    }
    if (EN(17) && IN(17)) REP(17) { PHASE_ARGS; norm_phase<true, true, false>(a, lds, vcu, G, tid, lane, wave, ws + WS_XB, nullptr, a.out(), a.in(I_FG), nullptr, 0, mod + 2 * 6144); }
#undef IN
#undef SEAM
}

extern "C" void kernel_launch(void* const* d_in, const int* in_sizes, int n_in, void* d_out, int out_size, void* d_ws, size_t ws_size, hipStream_t stream) {
    static int grid = 0;
    if (grid == 0) {
        if (n_in != 27 || in_sizes[0] != NTOK * D || out_size != NTOK * D || ws_size < WS_END) {
            fprintf(stderr, "kernel_launch: unexpected shapes (n_in %d, in0 %d, out %d, ws %zu < %zu); nothing launched\n", n_in, n_in > 0 ? in_sizes[0] : -1, out_size, ws_size, (size_t)WS_END); grid = -1; return; }
        int dev = 0, cus = 0, per_cu = 0;
        if (hipGetDevice(&dev) != hipSuccess || hipDeviceGetAttribute(&cus, hipDeviceAttributeMultiprocessorCount, dev) != hipSuccess) { grid = -1; return; }
#if MK_MULTI
#define SET_ATTR(p) ok = ok && (hipFuncSetAttribute((const void*)fwd_kernel<p, p + 1>, hipFuncAttributeMaxDynamicSharedMemorySize, LDS_BYTES) == hipSuccess)
        bool ok = true; SET_ATTR(0); SET_ATTR(1); SET_ATTR(2); SET_ATTR(3); SET_ATTR(4); SET_ATTR(5); SET_ATTR(6); SET_ATTR(7); SET_ATTR(8); SET_ATTR(9);
        SET_ATTR(10); SET_ATTR(11); SET_ATTR(12); SET_ATTR(13); SET_ATTR(14); SET_ATTR(15); SET_ATTR(16); SET_ATTR(17);
        if (!ok) { fprintf(stderr, "kernel_launch: hipFuncSetAttribute failed\n"); grid = -1; return; }
        per_cu = 1;
#else
        if (hipFuncSetAttribute((const void*)fwd_kernel<0, NPH>, hipFuncAttributeMaxDynamicSharedMemorySize, LDS_BYTES) != hipSuccess) { fprintf(stderr, "kernel_launch: hipFuncSetAttribute failed\n"); grid = -1; return; }
        if (hipOccupancyMaxActiveBlocksPerMultiprocessor(&per_cu, (const void*)fwd_kernel<0, NPH>, NWAVES * 64, LDS_BYTES) != hipSuccess || per_cu < 1)
            fprintf(stderr, "kernel_launch: note: occupancy query reports %d workgroups per CU\n", per_cu);
#endif
        (void)hipGetLastError();
        grid = cus;
    }
    if (grid < 0) return;
    if (hipMemsetAsync((char*)d_ws + WS_CTL, 0, CTL_ZERO_BYTES, stream) != hipSuccess) return;
    Args a{};
    for (int i = 0; i < 27; ++i) a.in[i] = (const float*)d_in[i];
    a.out = (float*)d_out; a.ws = (unsigned char*)d_ws;
#if MK_MULTI
#define LAUNCH_PH(p) do { a.ph_lo = p; a.ph_hi = p + 1; hipLaunchKernelGGL((fwd_kernel<p, p + 1>), dim3(grid), dim3(NWAVES * 64), LDS_BYTES, stream, a); } while (0)
    LAUNCH_PH(0); LAUNCH_PH(1); LAUNCH_PH(2); LAUNCH_PH(3); LAUNCH_PH(4); LAUNCH_PH(5); LAUNCH_PH(6); LAUNCH_PH(7); LAUNCH_PH(8); LAUNCH_PH(9);
    LAUNCH_PH(10); LAUNCH_PH(11); LAUNCH_PH(12); LAUNCH_PH(13); LAUNCH_PH(14); LAUNCH_PH(15); LAUNCH_PH(16); LAUNCH_PH(17);
#else
    a.ph_lo = 0; a.ph_hi = NPH;
    hipLaunchKernelGGL((fwd_kernel<0, NPH>), dim3(grid), dim3(NWAVES * 64), LDS_BYTES, stream, a);
#endif
}
```
